# Optimizing an MI355X kernel written in HIP

```python
import jax, jax.numpy as jnp
from jax import lax
import numpy as np

D_MODEL = 1024
BATCH = 4
SEQ = 4096
DEPTH = 1

GRID_W = 64
CTX_LEN = 256
NA_HEADS = 8
NA_HEAD_DIM = 64
NA_WIDTH = NA_HEADS * NA_HEAD_DIM
NA_WIN_ROWS = 8
NA_WIN_COLS = 16
LRU_WIDTH = D_MODEL
LRU_BLOCKS = 8
LRU_BLOCK = LRU_WIDTH // LRU_BLOCKS
CONV_WIDTH = 4
CONV_LEFT = 2
LRU_C = 8.0
PEER_HEADS = 8
PEER_NKEYS = 128
PEER_EXPERTS = PEER_NKEYS * PEER_NKEYS
PEER_QDIM = 256
PEER_HALF = PEER_QDIM // 2
PEER_TOPK = 16
PEER_CHUNK = 128
EPS = 1e-6
NEG_INF = -1e30

Q0 = 0
K0 = Q0 + NA_WIDTH
V0 = K0 + NA_WIDTH
XR0 = V0 + NA_WIDTH
YR0 = XR0 + LRU_WIDTH
GA0 = YR0 + LRU_WIDTH
GB0 = GA0 + D_MODEL
IN_COLS = GB0 + D_MODEL

kernel_name = "hybrid_na_rglru_peer_dit_block"


def rms_norm(x, w):
    xf = x.astype(jnp.float32)
    y = xf * lax.rsqrt(jnp.mean(xf * xf, axis=-1, keepdims=True) + EPS)
    return (y * w.astype(jnp.float32)).astype(x.dtype)


def modulate(h, shift, scale):
    return h * (1.0 + scale[:, None, :]) + shift[:, None, :]


def dwconv_centred(u, w, b):
    T = u.shape[1]
    up = jnp.pad(u, ((0, 0), (CONV_LEFT, CONV_WIDTH - 1 - CONV_LEFT), (0, 0)))
    out = b
    for j in range(CONV_WIDTH):
        out = out + w[j] * up[:, j:j + T]
    return out


def rglru_coeffs(u, w_a, b_a, w_x, b_x, lam):
    B, T, W = u.shape
    uf = u.astype(jnp.float32)
    ub = uf.reshape(B, T, LRU_BLOCKS, LRU_BLOCK)
    r = jax.nn.sigmoid(jnp.einsum('btnc,ncd->btnd', ub, w_a.astype(jnp.float32)).reshape(B, T, W) + b_a)
    i = jax.nn.sigmoid(jnp.einsum('btnc,ncd->btnd', ub, w_x.astype(jnp.float32)).reshape(B, T, W) + b_x)
    log_a = -LRU_C * r * jax.nn.softplus(-lam.astype(jnp.float32))
    a = jnp.exp(log_a)
    beta = jnp.sqrt(-jnp.expm1(2.0 * log_a))
    return a, beta * (i * uf)


def linear_scan(a, b, reverse):
    def combine(left, right):
        a_l, b_l = left
        a_r, b_r = right
        return a_l * a_r, a_r * b_l + b_r
    _, h = lax.associative_scan(combine, (a, b), reverse=reverse, axis=1)
    return h


def rglru_bidirectional(u_lat, u_ctx, w_a, b_a, w_x, b_x, lam):
    out = None
    for d, rev in enumerate((False, True)):
        a_c, b_c = rglru_coeffs(u_ctx, w_a[d], b_a[d], w_x[d], b_x[d], lam[d])
        h_c = linear_scan(a_c, b_c, rev)
        a_l, b_l = rglru_coeffs(u_lat, w_a[d], b_a[d], w_x[d], b_x[d], lam[d])
        if rev:
            b_l = b_l.at[:, -1].add(a_l[:, -1] * h_c[:, 0])
        else:
            b_l = b_l.at[:, 0].add(a_l[:, 0] * h_c[:, -1])
        h_l = linear_scan(a_l, b_l, rev)
        out = h_l if out is None else out + h_l
    return out


def neighbourhood_attention(q, k, v, k_ctx, v_ctx, rpb):
    B, S = q.shape[0], q.shape[1]
    rows = S // GRID_W
    wr = min(NA_WIN_ROWS, rows)
    wc = NA_WIN_COLS
    grid = lambda t: t.reshape(B, rows, GRID_W, NA_HEADS, NA_HEAD_DIM)
    qg, kg, vg = grid(q), grid(k), grid(v)
    r = jnp.arange(rows)
    row0 = jnp.clip(r - wr // 2, 0, rows - wr)
    key_rows = row0[:, None] + jnp.arange(wr)
    k_strip = kg[:, key_rows]
    v_strip = vg[:, key_rows]
    col = jnp.arange(GRID_W)
    col0 = jnp.clip(col - wc // 2, 0, GRID_W - wc)
    col_mask = (col[None, :] >= col0[:, None]) & (col[None, :] < col0[:, None] + wc)
    dr = key_rows - r[:, None]
    dc = jnp.clip(col[None, :] - col[:, None], -(wc - 1), wc - 1)
    bias = rpb[:, dr[:, None, :, None] + NA_WIN_ROWS - 1,
               dc[None, :, None, :] + NA_WIN_COLS - 1]
    scale = NA_HEAD_DIM ** -0.5
    s_win = jnp.einsum('brqhd,brwkhd->bhrqwk', qg, k_strip).astype(jnp.float32) * scale
    s_win = jnp.where(col_mask[:, None, :], s_win + bias.astype(jnp.float32), NEG_INF)
    s_ctx = jnp.einsum('brqhd,bchd->bhrqc', qg, k_ctx).astype(jnp.float32) * scale
    n_win = wr * GRID_W
    s = jnp.concatenate([s_win.reshape(B, NA_HEADS, rows, GRID_W, n_win), s_ctx], axis=-1)
    p = jax.nn.softmax(s, axis=-1).astype(v.dtype)
    p_win = p[..., :n_win].reshape(B, NA_HEADS, rows, GRID_W, wr, GRID_W)
    p_ctx = p[..., n_win:]
    o = (jnp.einsum('bhrqwk,brwkhd->brqhd', p_win, v_strip)
         + jnp.einsum('bhrqc,bchd->brqhd', p_ctx, v_ctx))
    return o.reshape(B, S, NA_WIDTH)


def peer(h, w_q, keys, u, v):
    B, S, D = h.shape
    q = (h @ w_q).reshape(B, S, PEER_HEADS, 2, PEER_HALF)
    s = jnp.einsum('bshpd,hpkd->bshpk', q, keys).astype(jnp.float32)
    top_s, top_i = lax.top_k(s, PEER_TOPK)
    cand_s = (top_s[..., 0, :, None] + top_s[..., 1, None, :]).reshape(B, S, PEER_HEADS, PEER_TOPK * PEER_TOPK)
    cand_i = (top_i[..., 0, :, None] * PEER_NKEYS + top_i[..., 1, None, :]).reshape(B, S, PEER_HEADS, PEER_TOPK * PEER_TOPK)
    best_s, pos = lax.top_k(cand_s, PEER_TOPK)
    expert = jnp.take_along_axis(cand_i, pos, axis=-1)
    gate = jax.nn.softmax(best_s, axis=-1).astype(h.dtype)
    n_chunks = (B * S) // PEER_CHUNK

    def chunk(args):
        hc, ec, gc = args
        act = jax.nn.gelu(jnp.einsum('td,thkd->thk', hc, u[ec]))
        return jnp.einsum('thk,thkd->td', gc * act, v[ec])

    y = lax.map(chunk, (h.reshape(n_chunks, PEER_CHUNK, D),
                        expert.reshape(n_chunks, PEER_CHUNK, PEER_HEADS, PEER_TOPK),
                        gate.reshape(n_chunks, PEER_CHUNK, PEER_HEADS, PEER_TOPK)))
    return y.reshape(B, S, D)


def setup_inputs(seed: int = 0) -> dict:
    key = jax.random.key(seed)
    ks = jax.random.split(key, 26)
    nrm = lambda k, shape, s: jax.random.normal(k, shape, jnp.float32) * s
    a0 = jax.random.uniform(ks[18], (DEPTH, 2, LRU_WIDTH), jnp.float32, 0.9, 0.999)
    p0 = a0 ** (1.0 / LRU_C)
    return {
        "x": nrm(ks[0], (BATCH, SEQ, D_MODEL), 1.0),
        "c": nrm(ks[1], (BATCH, D_MODEL), 1.0),
        "ctx": nrm(ks[2], (BATCH, CTX_LEN, D_MODEL), 1.0),
        "c_ctx": nrm(ks[3], (D_MODEL,), 1.0),
        "w_ada": nrm(ks[4], (DEPTH, D_MODEL, 6 * D_MODEL), 0.5 * D_MODEL ** -0.5),
        "b_ada": nrm(ks[5], (DEPTH, 6 * D_MODEL), 0.02),
        "norm1_w": 1.0 + nrm(ks[6], (DEPTH, D_MODEL), 0.02),
        "norm2_w": 1.0 + nrm(ks[7], (DEPTH, D_MODEL), 0.02),
        "w_in": nrm(ks[8], (DEPTH, D_MODEL, IN_COLS), D_MODEL ** -0.5),
        "q_norm_w": 1.0 + nrm(ks[9], (DEPTH, NA_HEAD_DIM), 0.02),
        "k_norm_w": 1.0 + nrm(ks[10], (DEPTH, NA_HEAD_DIM), 0.02),
        "na_rpb": nrm(ks[11], (DEPTH, NA_HEADS, 2 * NA_WIN_ROWS - 1, 2 * NA_WIN_COLS - 1), 0.1),
        "conv_w": nrm(ks[12], (DEPTH, CONV_WIDTH, LRU_WIDTH), CONV_WIDTH ** -0.5),
        "conv_b": nrm(ks[13], (DEPTH, LRU_WIDTH), 0.02),
        "lru_w_a": nrm(ks[14], (DEPTH, 2, LRU_BLOCKS, LRU_BLOCK, LRU_BLOCK), LRU_BLOCK ** -0.5),
        "lru_b_a": nrm(ks[15], (DEPTH, 2, LRU_WIDTH), 0.02),
        "lru_w_x": nrm(ks[16], (DEPTH, 2, LRU_BLOCKS, LRU_BLOCK, LRU_BLOCK), LRU_BLOCK ** -0.5),
        "lru_b_x": nrm(ks[17], (DEPTH, 2, LRU_WIDTH), 0.02),
        "lru_lambda": jnp.log(p0) - jnp.log1p(-p0),
        "w_o_attn": nrm(ks[19], (DEPTH, NA_WIDTH, D_MODEL), NA_WIDTH ** -0.5),
        "w_o_lru": nrm(ks[20], (DEPTH, LRU_WIDTH, D_MODEL), LRU_WIDTH ** -0.5),
        "w_out": nrm(ks[21], (DEPTH, D_MODEL, D_MODEL), D_MODEL ** -0.5),
        "peer_w_q": nrm(ks[22], (DEPTH, D_MODEL, PEER_HEADS * PEER_QDIM), D_MODEL ** -0.5),
        "peer_keys": nrm(ks[23], (DEPTH, PEER_HEADS, 2, PEER_NKEYS, PEER_HALF), PEER_HALF ** -0.5),
        "peer_u": nrm(ks[24], (DEPTH, PEER_EXPERTS, D_MODEL), D_MODEL ** -0.5),
        "peer_v": nrm(ks[25], (DEPTH, PEER_EXPERTS, D_MODEL), PEER_HEADS ** -0.5),
    }


def reference(x, c, ctx, c_ctx, w_ada, b_ada, norm1_w, norm2_w, w_in, q_norm_w, k_norm_w, na_rpb,
              conv_w, conv_b, lru_w_a, lru_b_a, lru_w_x, lru_b_x, lru_lambda, w_o_attn, w_o_lru,
              w_out, peer_w_q, peer_keys, peer_u, peer_v):
    B, S, D = x.shape
    C = ctx.shape[1]
    for layer in range(DEPTH):
        mod = jax.nn.silu(c) @ w_ada[layer] + b_ada[layer]
        shift1, scale1, gate1, shift2, scale2, gate2 = jnp.split(mod, 6, axis=-1)
        mod_c = jax.nn.silu(c_ctx) @ w_ada[layer] + b_ada[layer]
        shift1_c, scale1_c = mod_c[:D], mod_c[D:2 * D]

        h = modulate(rms_norm(x, norm1_w[layer]), shift1, scale1)
        z = h @ w_in[layer]
        hc = rms_norm(ctx, norm1_w[layer]) * (1.0 + scale1_c) + shift1_c
        zc = hc @ w_in[layer][:, K0:YR0]

        q = rms_norm(z[..., Q0:K0].reshape(B, S, NA_HEADS, NA_HEAD_DIM), q_norm_w[layer])
        k = rms_norm(z[..., K0:V0].reshape(B, S, NA_HEADS, NA_HEAD_DIM), k_norm_w[layer])
        v = z[..., V0:XR0].reshape(B, S, NA_HEADS, NA_HEAD_DIM)
        k_c = rms_norm(zc[..., :NA_WIDTH].reshape(B, C, NA_HEADS, NA_HEAD_DIM), k_norm_w[layer])
        v_c = zc[..., NA_WIDTH:2 * NA_WIDTH].reshape(B, C, NA_HEADS, NA_HEAD_DIM)
        o_a = neighbourhood_attention(q, k, v, k_c, v_c, na_rpb[layer])

        u = dwconv_centred(z[..., XR0:YR0], conv_w[layer], conv_b[layer])
        u_c = dwconv_centred(zc[..., 2 * NA_WIDTH:], conv_w[layer], conv_b[layer])
        h_r = rglru_bidirectional(u, u_c, lru_w_a[layer], lru_b_a[layer], lru_w_x[layer],
                                  lru_b_x[layer], lru_lambda[layer])
        o_b = h_r.astype(x.dtype) * jax.nn.gelu(z[..., YR0:GA0])

        merged = (jax.nn.sigmoid(z[..., GA0:GB0]) * (o_a @ w_o_attn[layer])
                  + jax.nn.sigmoid(z[..., GB0:]) * (o_b @ w_o_lru[layer]))
        x = x + gate1[:, None, :] * (merged @ w_out[layer])

        h2 = modulate(rms_norm(x, norm2_w[layer]), shift2, scale2)
        y = peer(h2, peer_w_q[layer], peer_keys[layer], peer_u[layer], peer_v[layer])
        x = x + gate2[:, None, :] * y
    return x
```

```cpp
#include <hip/hip_runtime.h>
#include <hip/hip_cooperative_groups.h>
#include <cstdio>
#include <cstdint>
namespace cg = cooperative_groups;

#ifndef PROBE_MASK
#define PROBE_MASK 0
#endif
#ifndef GP_SP2
#define GP_SP2 true
#endif
#ifndef GP_ALIGN
#define GP_ALIGN true
#endif
#ifndef MK_MULTI
#define MK_MULTI 0
#endif

#define LAS __attribute__((address_space(3)))
typedef __bf16 bf2_t __attribute__((ext_vector_type(2)));
typedef unsigned u32x2 __attribute__((ext_vector_type(2)));
typedef float f32x2 __attribute__((ext_vector_type(2)));

namespace pg8 {
#define PG8_LAS __attribute__((address_space(3)))
typedef unsigned short bf16_t;
typedef short bf16x8 __attribute__((ext_vector_type(8)));
typedef float f32x4 __attribute__((ext_vector_type(4)));
typedef unsigned u32x4 __attribute__((ext_vector_type(4)));
constexpr int BM = 256, BK = 64, HALF = 128, HTB = HALF * BK * 2  , STAGE_BYTES = 8 * HTB, NXCD = 8, WGM = 4;

__host__ __device__ __forceinline__ int lds_byte(int r, int c) { const int st = (r >> 4) * 2 + (c >> 5), rr = r & 15, cc = c & 31, ob = rr * 64 + cc * 2; return st * 1024 + (ob ^ (((ob >> 9) & 1) << 5)); }
__host__ __device__ __forceinline__ void stage_rc(int b, int& R, int& C) { const int st = b / 1024, sb = b % 1024, swz = sb ^ (((sb >> 9) & 1) << 5); R = (st >> 1) * 16 + swz / 64; C = (st & 1) * 32 + (swz % 64) / 2; }
__host__ __device__ __forceinline__ int perm32(int rho) { const int n = rho >> 4, i = rho & 15; return 8 * (i >> 2) + 4 * n + (i & 3); }

struct Unit { int pm, pn; };
struct Gemm { const bf16_t* A; const bf16_t* Bt; int M, N, K; };


struct StaticOrder {
    int nM, nN, nwg, G, c, wgm;
    __host__ __device__ __forceinline__ void init(int M, int N, int G_, int c_, int wgm_ = WGM) { nM = M / BM; nN = N / BM; nwg = nM * nN; G = G_; c = c_; wgm = wgm_; }
    __host__ __device__ __forceinline__ bool next(int i, Unit& u) const {
        const long L = (long)i * G + c; if (L >= nwg) return false;
        int wgid = (int)L; { const int q = nwg / NXCD, r = nwg % NXCD, xcd = wgid % NXCD, off = wgid / NXCD; wgid = (xcd < r ? xcd * (q + 1) : r * (q + 1) + (xcd - r) * q) + off; }
        const int nig = wgm * nN, gid = wgid / nig, fm = gid * wgm, gsz = (nM - fm) < wgm ? (nM - fm) : wgm;
        u.pm = fm + ((wgid % nig) % gsz); u.pn = (wgid % nig) / gsz; return true;
    }
    __device__ __forceinline__ void a_ready(const Unit&) const {}
    __device__ __forceinline__ void done(const Unit&) const {}
};
__device__ __forceinline__ unsigned cvt_pk_bf16(float lo, float hi) { unsigned r; asm volatile("v_cvt_pk_bf16_f32 %0, %1, %2" : "=v"(r) : "v"(lo), "v"(hi)); return r; }
template <class Epi, class Sched, bool ALIGN_EPI = false, bool SP2 = false>
__device__ __forceinline__ void gemm_phase(PG8_LAS unsigned char* lds, const Gemm g, const Sched& S, const Epi& E) {
    int tid_ = threadIdx.x; asm volatile("" : "+v"(tid_));
    const int tid = tid_, wid = __builtin_amdgcn_readfirstlane(tid >> 6), lane = tid & 63, wr = wid >> 2, wc = wid & 3, fr = lane & 15, fq = lane >> 4;
    const int K = g.K, nt = K / BK;
    unsigned voffA[2], voffB[2];
#pragma unroll
    for (int i = 0; i < 2; ++i) { int R, C; stage_rc(tid * 16 + i * 8192, R, C); const int Rb = Epi::PERM ? ((R & ~31) + perm32(R & 31)) : R;
        voffA[i] = (unsigned)(R * K + C) * 2u; voffB[i] = (unsigned)(Rb * K + C) * 2u; }
    const size_t kstep = (size_t)(BK * 2);
    const size_t hstep = (size_t)HALF * K * 2;
    const size_t tstep = 2 * hstep;
    const unsigned ldsw = (unsigned)wid * 1024u;
    const int aoff = lds_byte(wr * 64 + fr, fq * 8), boff = lds_byte(wc * 32 + fr, fq * 8);
#define PG8_SA(b, h) (((b) * 2 + (h)) * HTB)
#define PG8_SB(b, h) ((4 + (b) * 2 + (h)) * HTB)
#define PG8_STAGE(bufoff, gbase, voff) do { _Pragma("unroll") for (int _i = 0; _i < 2; ++_i) \
        __builtin_amdgcn_global_load_lds((const unsigned*)((const char*)(gbase) + (voff)[_i]), (PG8_LAS unsigned*)(lds + (bufoff) + ldsw + _i * 8192), 16, 0, 0); } while (0)
#define PG8_LDA(dst, b, h) do { _Pragma("unroll") for (int m = 0; m < 4; ++m) _Pragma("unroll") for (int k = 0; k < 2; ++k) dst[m][k] = *(const PG8_LAS bf16x8*)(lds + PG8_SA(b, h) + aoff + m * 2048 + k * 1024); } while (0)
#define PG8_LDB(dst, b, h) do { _Pragma("unroll") for (int n = 0; n < 2; ++n) _Pragma("unroll") for (int k = 0; k < 2; ++k) dst[n][k] = *(const PG8_LAS bf16x8*)(lds + PG8_SB(b, h) + boff + n * 2048 + k * 1024); } while (0)
#define PG8_MMA(ai, bj, At, Bt) do { __builtin_amdgcn_s_setprio(1); _Pragma("unroll") for (int m = 0; m < 4; ++m) _Pragma("unroll") for (int n = 0; n < 2; ++n) _Pragma("unroll") for (int k = 0; k < 2; ++k) \
        acc[ai][bj][m][n] = __builtin_amdgcn_mfma_f32_16x16x32_bf16(Bt[n][k], At[m][k], acc[ai][bj][m][n], 0, 0, 0); __builtin_amdgcn_s_setprio(0); } while (0)
#define PG8_WAIT_V(n) asm volatile("s_waitcnt vmcnt(" #n ")" ::: "memory")
#define PG8_WAIT_L(n) asm volatile("s_waitcnt lgkmcnt(" #n ")" ::: "memory")
#define PG8_BAR __builtin_amdgcn_s_barrier()
#define PG8_SCHED __builtin_amdgcn_sched_barrier(0)
    Unit cur, nxt; int ui = 0;
    if (!S.next(0, cur)) return;
    f32x4 acc[2][2][4][2];
#pragma unroll
    for (int a = 0; a < 2; ++a)
#pragma unroll
        for (int b = 0; b < 2; ++b)
#pragma unroll
            for (int m = 0; m < 4; ++m)
#pragma unroll
                for (int n = 0; n < 2; ++n) acc[a][b][m][n] = (f32x4){0.f, 0.f, 0.f, 0.f};
    bf16x8 At[4][2], B0[2][2], B1[2][2];
    const char* cA = (const char*)g.A + (size_t)cur.pm * tstep; const char* cB = (const char*)g.Bt + (size_t)cur.pn * tstep;
    S.a_ready(cur);
    if constexpr (SP2) {
        PG8_STAGE(PG8_SB(0, 0), cB, voffB); PG8_STAGE(PG8_SB(0, 1), cB + hstep, voffB); PG8_STAGE(PG8_SA(0, 0), cA, voffA); PG8_STAGE(PG8_SA(0, 1), cA + hstep, voffA);
        if (wr == 1) PG8_BAR;
        PG8_WAIT_V(2); PG8_BAR;
        PG8_STAGE(PG8_SB(1, 0), cB + kstep, voffB); PG8_STAGE(PG8_SA(1, 0), cA + kstep, voffA); PG8_STAGE(PG8_SB(1, 1), cB + hstep + kstep, voffB);
        PG8_WAIT_V(6); PG8_BAR;
    } else {
        PG8_STAGE(PG8_SB(0, 0), cB, voffB); PG8_STAGE(PG8_SA(0, 0), cA, voffA); PG8_STAGE(PG8_SB(0, 1), cB + hstep, voffB); PG8_STAGE(PG8_SA(0, 1), cA + hstep, voffA);
        if (wr == 1) PG8_BAR;
        PG8_WAIT_V(4); PG8_BAR;
        PG8_STAGE(PG8_SB(1, 0), cB + kstep, voffB); PG8_STAGE(PG8_SA(1, 0), cA + kstep, voffA); PG8_STAGE(PG8_SB(1, 1), cB + hstep + kstep, voffB);
        PG8_WAIT_V(6); PG8_BAR;
    }
    for (;;) {
        const bool has_next = S.next(ui + 1, nxt);
        const char* nA = has_next ? (const char*)g.A + (size_t)nxt.pm * tstep : cA; const char* nB = has_next ? (const char*)g.Bt + (size_t)nxt.pn * tstep : cB;
        for (int t = 0; t < nt; t += 2) {
            const bool last = (t == nt - 2);
            const char* a1 = cA + (size_t)(t + 1) * kstep;
            const char* a2 = last ? nA : cA + (size_t)(t + 2) * kstep; const char* b2 = last ? nB : cB + (size_t)(t + 2) * kstep;
            const char* a3 = a2 + kstep; const char* b3 = b2 + kstep;
            if (last && has_next) S.a_ready(nxt);
            if constexpr (SP2) {
            PG8_LDB(B0, 0, 0); PG8_LDB(B1, 0, 1); PG8_SCHED; PG8_LDA(At, 0, 0); PG8_STAGE(PG8_SA(1, 1), a1 + hstep, voffA);
            PG8_WAIT_V(8); PG8_WAIT_L(0); PG8_BAR; PG8_MMA(0, 0, At, B0); PG8_MMA(0, 1, At, B1); PG8_BAR; PG8_SCHED;
            PG8_LDA(At, 0, 1); PG8_STAGE(PG8_SB(0, 0), b2, voffB); PG8_STAGE(PG8_SB(0, 1), b2 + hstep, voffB); PG8_STAGE(PG8_SA(0, 0), a2, voffA);
            PG8_WAIT_V(8); PG8_WAIT_L(0); PG8_BAR; PG8_MMA(1, 0, At, B0); PG8_MMA(1, 1, At, B1); PG8_BAR; PG8_SCHED;
            PG8_LDB(B0, 1, 0); PG8_LDB(B1, 1, 1); PG8_SCHED; PG8_LDA(At, 1, 0); PG8_STAGE(PG8_SA(0, 1), a2 + hstep, voffA);
            PG8_WAIT_V(8); PG8_WAIT_L(0); PG8_BAR; PG8_MMA(0, 0, At, B0); PG8_MMA(0, 1, At, B1); PG8_BAR; PG8_SCHED;
            PG8_LDA(At, 1, 1); PG8_STAGE(PG8_SB(1, 0), b3, voffB); PG8_STAGE(PG8_SB(1, 1), b3 + hstep, voffB); PG8_STAGE(PG8_SA(1, 0), a3, voffA);
            PG8_WAIT_V(8); PG8_WAIT_L(0); PG8_BAR; PG8_MMA(1, 0, At, B0); PG8_MMA(1, 1, At, B1); PG8_BAR; PG8_SCHED;
            } else {
            PG8_LDB(B0, 0, 0); PG8_SCHED; PG8_LDA(At, 0, 0); PG8_STAGE(PG8_SA(1, 1), a1 + hstep, voffA);
            PG8_WAIT_L(8); PG8_BAR; PG8_WAIT_L(0); PG8_MMA(0, 0, At, B0); PG8_BAR; PG8_SCHED;
            PG8_LDB(B1, 0, 1); PG8_STAGE(PG8_SB(0, 0), b2, voffB);
            PG8_BAR; PG8_WAIT_L(0); PG8_MMA(0, 1, At, B1); PG8_BAR;
            PG8_LDA(At, 0, 1); PG8_STAGE(PG8_SA(0, 0), a2, voffA);
            PG8_BAR; PG8_WAIT_L(0); PG8_MMA(1, 0, At, B0); PG8_BAR; PG8_SCHED;
            PG8_STAGE(PG8_SB(0, 1), b2 + hstep, voffB);
            PG8_WAIT_V(6); PG8_BAR; PG8_MMA(1, 1, At, B1); PG8_BAR;
            PG8_LDB(B0, 1, 0); PG8_SCHED; PG8_LDA(At, 1, 0); PG8_STAGE(PG8_SA(0, 1), a2 + hstep, voffA);
            PG8_WAIT_L(8); PG8_BAR; PG8_WAIT_L(0); PG8_MMA(0, 0, At, B0); PG8_BAR; PG8_SCHED;
            PG8_LDB(B1, 1, 1); PG8_STAGE(PG8_SB(1, 0), b3, voffB);
            PG8_BAR; PG8_WAIT_L(0); PG8_MMA(0, 1, At, B1); PG8_BAR;
            PG8_LDA(At, 1, 1); PG8_STAGE(PG8_SA(1, 0), a3, voffA);
            PG8_BAR; PG8_WAIT_L(0); PG8_MMA(1, 0, At, B0); PG8_BAR; PG8_SCHED;
            PG8_STAGE(PG8_SB(1, 1), b3 + hstep, voffB);
            PG8_WAIT_V(6); PG8_BAR; PG8_MMA(1, 1, At, B1); PG8_BAR;
            }
        }
        if constexpr (ALIGN_EPI) { if (wr == 0) PG8_BAR; }
        if constexpr (!Epi::AFTER_DRAIN) { E(acc, cur, wr, wc, fr, fq); S.done(cur); }
        if (!has_next) break;
#pragma unroll
        for (int a = 0; a < 2; ++a)
#pragma unroll
            for (int b = 0; b < 2; ++b)
#pragma unroll
                for (int m = 0; m < 4; ++m)
#pragma unroll
                    for (int n = 0; n < 2; ++n) acc[a][b][m][n] = (f32x4){0.f, 0.f, 0.f, 0.f};
        cur = nxt; cA = nA; cB = nB; ++ui;
        if constexpr (ALIGN_EPI) { if (wr == 1) PG8_BAR; }
    }
    PG8_WAIT_V(0);
    if constexpr (!ALIGN_EPI) { if (wr == 0) PG8_BAR; }
    PG8_BAR;
    if constexpr (Epi::AFTER_DRAIN) { E.fused(acc, cur, wr, wc, fr, fq, lds, wid, lane); S.done(cur); }
#undef PG8_SA
#undef PG8_SB
#undef PG8_STAGE
#undef PG8_LDA
#undef PG8_LDB
#undef PG8_MMA
#undef PG8_WAIT_V
#undef PG8_WAIT_L
#undef PG8_BAR
#undef PG8_SCHED
}

}
using pg8::bf16_t; using pg8::bf16x8; using pg8::f32x4; using pg8::u32x4; using pg8::Unit; using pg8::cvt_pk_bf16;

constexpr int DM = 1024, NB = 4, SEQ = 4096, CTX = 256, NT = NB * SEQ, NC = NB * CTX, NR = NT + NC, SP = SEQ + CTX;
constexpr int INC = 5632;
constexpr float EPS = 1e-6f;
constexpr int LDS_BYTES = 147456;

constexpr size_t al256(size_t x) { return (x + 255) & ~(size_t)255; }
constexpr size_t OFF_MOD = 0;
constexpr size_t OFF_QSS = al256(OFF_MOD + 5 * 6144 * 4);
constexpr size_t OFF_KSS = al256(OFF_QSS + (size_t)NB * 8 * SP * 4);
constexpr size_t OFF_CHK = al256(OFF_KSS + (size_t)NB * 8 * SP * 4);
constexpr size_t OFF_WINT = al256(OFF_CHK + (size_t)NB * 68 * 4 * 1024 * 4);
constexpr size_t OFF_WOAT = al256(OFF_WINT + (size_t)INC * 1024 * 2);
constexpr size_t OFF_WOLT = al256(OFF_WOAT + (size_t)1024 * 512 * 2);
constexpr size_t OFF_WOUTT = al256(OFF_WOLT + (size_t)1024 * 1024 * 2);
constexpr size_t OFF_WPQT = al256(OFF_WOUTT + (size_t)1024 * 1024 * 2);
constexpr size_t OFF_KEYS = al256(OFF_WPQT + (size_t)2048 * 1024 * 2);
constexpr size_t OFF_LRUW = al256(OFF_KEYS + (size_t)8 * 2 * 128 * 128 * 2);
constexpr size_t OFF_HBUF = al256(OFF_LRUW + (size_t)32 * 128 * 128 * 2);
constexpr size_t OFF_Q = al256(OFF_HBUF + (size_t)NR * 1024 * 2);
constexpr size_t OFF_K = al256(OFF_Q + (size_t)NT * 512 * 2);
constexpr size_t OFF_VT = al256(OFF_K + (size_t)NB * SP * 512 * 2);
constexpr size_t OFF_OA = al256(OFF_VT + (size_t)NB * 8 * 64 * SP * 2);
constexpr size_t OFF_XR = al256(OFF_OA + (size_t)NT * 512 * 2);
constexpr size_t OFF_YG = al256(OFF_XR + (size_t)NR * 1024 * 2);
constexpr size_t OFF_BAR = al256(OFF_YG + (size_t)NT * 1024 * 2);
constexpr size_t OFF_LRD = al256(OFF_BAR + 16384);
constexpr size_t WS_END = al256(OFF_LRD + (size_t)2048 * 4 * 512 * 16);
static_assert(OFF_XR - OFF_Q >= (size_t)2 * 16384 * 1024 * 2, "u/v overlay");
static_assert(OFF_VT - OFF_Q >= (size_t)NT * 1024 * 2, "T1 overlay on q|k");
static_assert(OFF_BAR - OFF_XR >= (size_t)NT * 2048 * 2, "q_p overlay");
static_assert(WS_END <= (size_t)275000000, "workspace (ws_size >= sum of the inputs = 275.8 MB)");

struct Params {
    const float *x, *c, *ctx, *c_ctx, *w_ada, *b_ada, *norm1_w, *norm2_w, *w_in, *q_norm_w, *k_norm_w, *na_rpb, *conv_w, *conv_b,
        *lru_w_a, *lru_b_a, *lru_w_x, *lru_b_x, *lru_lambda, *w_o_attn, *w_o_lru, *w_out, *peer_w_q, *peer_keys, *peer_u, *peer_v;
    float* out; unsigned char* ws;
};

__device__ __forceinline__ float bf2f(unsigned short h) { return __uint_as_float(((unsigned)h) << 16); }
__device__ __forceinline__ float bflo(unsigned w) { return __uint_as_float(w << 16); }
__device__ __forceinline__ float bfhi(unsigned w) { return __uint_as_float(w & 0xffff0000u); }
__device__ __forceinline__ float sigmoidf_(float x) { return __builtin_amdgcn_rcpf(1.f + __expf(-x)); }
__device__ __forceinline__ float gelu_tanh(float x) { const float z = 0.7978845608f * (x + 0.044715f * x * x * x); return x * __builtin_amdgcn_rcpf(1.f + __expf(-2.f * z)); }
__device__ __forceinline__ float silu_(float x) { return x * sigmoidf_(x); }
__device__ __forceinline__ u32x4 pack8(const f32x4& a, const f32x4& b) { u32x4 w; w.x = cvt_pk_bf16(a[0], a[1]); w.y = cvt_pk_bf16(a[2], a[3]); w.z = cvt_pk_bf16(b[0], b[1]); w.w = cvt_pk_bf16(b[2], b[3]); return w; }

struct G1Order {
    pg8::StaticOrder so; int G, c;
    __device__ __forceinline__ void init(int G_, int c_) { so.init(NT, INC, G_, c_, 4); G = G_; c = c_; }
    __device__ __forceinline__ bool next(int i, Unit& u) const {
        long L = (long)i * G + c;
        if (L < 1408) return so.next(i, u);
        L -= 1408; if (L >= 32) return false;
        u.pm = 64 + (int)(L & 3); u.pn = 2 + (int)(L >> 2); return true;
    }
    __device__ __forceinline__ void a_ready(const Unit&) const {}
    __device__ __forceinline__ void done(const Unit&) const {}
};

struct EpiG1 {
    static constexpr bool PERM = true, AFTER_DRAIN = false;
    unsigned char* ws; unsigned char* outb; bool dummy;
    __device__ __forceinline__ void operator()(const f32x4 (&acc)[2][2][4][2], const Unit& u, int wr, int wc, int fr, int fq) const {
        const int pn = u.pn, pm = u.pm; const bool lat = pm < 64;
        bf16_t* const vT = (bf16_t*)(ws + OFF_VT);
        const int b = lat ? (pm >> 4) : (pm - 64), tok0 = lat ? ((pm & 15) << 8) : 4096;
        const int cu0 = wc * 32 + fq * 8;
        if (pn < 4) {
            const bool isq = pn < 2; bf16_t* dst = (bf16_t*)(ws + (isq ? OFF_Q : OFF_K)); float* ss = (float*)(ws + (isq ? OFF_QSS : OFF_KSS)); const int colbase = (pn & 1) * 256;
#pragma unroll
            for (int ai = 0; ai < 2; ++ai)
#pragma unroll
                for (int m = 0; m < 4; ++m) { const int tokp = tok0 + ai * 128 + wr * 64 + m * 16 + fr;
                    const size_t rowoff = isq ? (size_t)(b * SEQ + tokp) * 512 : (size_t)(b * SP + tokp) * 512;
#pragma unroll
                    for (int bj = 0; bj < 2; ++bj) { const int col = colbase + bj * 128 + cu0; const f32x4 v0 = acc[ai][bj][m][0], v1 = acc[ai][bj][m][1];
                        __builtin_nontemporal_store(pack8(v0, v1), (u32x4*)(dst + rowoff + col));
                        float s = v0[0] * v0[0] + v0[1] * v0[1] + v0[2] * v0[2] + v0[3] * v0[3] + v1[0] * v1[0] + v1[1] * v1[1] + v1[2] * v1[2] + v1[3] * v1[3];
                        s += __shfl_xor(s, 16); s += __shfl_xor(s, 32);
                        if (fq == 0 && !dummy) atomicAdd(ss + (size_t)(b * 8 + (col >> 6)) * SP + tokp, s); } }
        } else if (pn < 6) {
#pragma unroll
            for (int ai = 0; ai < 2; ++ai)
#pragma unroll
                for (int m = 0; m < 4; ++m) { const int tokp = tok0 + ai * 128 + wr * 64 + m * 16 + fr;
#pragma unroll
                    for (int bj = 0; bj < 2; ++bj) { const int col = (pn - 4) * 256 + bj * 128 + cu0; const int head = col >> 6, d0 = col & 63;
                        bf16_t* vp = vT + ((size_t)(b * 8 + head) * 64 + d0) * SP + tokp;
                        const u32x4 w = pack8(acc[ai][bj][m][0], acc[ai][bj][m][1]);
                        vp[0 * SP] = (bf16_t)(w.x & 0xffff); vp[1 * SP] = (bf16_t)(w.x >> 16); vp[2 * SP] = (bf16_t)(w.y & 0xffff); vp[3 * SP] = (bf16_t)(w.y >> 16);
                        vp[4 * SP] = (bf16_t)(w.z & 0xffff); vp[5 * SP] = (bf16_t)(w.z >> 16); vp[6 * SP] = (bf16_t)(w.w & 0xffff); vp[7 * SP] = (bf16_t)(w.w >> 16); } }
        } else {
            const int kind = (pn - 6) >> 2;
            bf16_t* dst = kind < 2 ? (bf16_t*)(ws + (kind == 0 ? OFF_XR : OFF_YG)) : (bf16_t*)(outb + (kind == 2 ? (size_t)0 : (size_t)NT * 1024 * 2)); const int colbase = ((pn - 6) & 3) * 256;
#pragma unroll
            for (int ai = 0; ai < 2; ++ai)
#pragma unroll
                for (int m = 0; m < 4; ++m) { const size_t row = (size_t)pm * 256 + ai * 128 + wr * 64 + m * 16 + fr;
#pragma unroll
                    for (int bj = 0; bj < 2; ++bj) { const int col = colbase + bj * 128 + cu0; f32x4 v0 = acc[ai][bj][m][0], v1 = acc[ai][bj][m][1];
                        if (kind == 1) {
#pragma unroll
                            for (int j = 0; j < 4; ++j) { v0[j] = gelu_tanh(v0[j]); v1[j] = gelu_tanh(v1[j]); } }
                        else if (kind >= 2) {
#pragma unroll
                            for (int j = 0; j < 4; ++j) { v0[j] = sigmoidf_(v0[j]); v1[j] = sigmoidf_(v1[j]); } }
                        __builtin_nontemporal_store(pack8(v0, v1), (u32x4*)(dst + row * 1024 + col)); } }
        }
    }
};

template <int MODE> struct EpiBf {
    static constexpr bool PERM = true, AFTER_DRAIN = false;
    bf16_t* dst; const bf16_t* gate; const bf16_t* add; int ldc;
    __device__ __forceinline__ void operator()(const f32x4 (&acc)[2][2][4][2], const Unit& u, int wr, int wc, int fr, int fq) const {
#pragma unroll
        for (int ai = 0; ai < 2; ++ai)
#pragma unroll
            for (int m = 0; m < 4; ++m) { const size_t row = (size_t)u.pm * 256 + ai * 128 + wr * 64 + m * 16 + fr;
#pragma unroll
                for (int bj = 0; bj < 2; ++bj) { const size_t off = row * ldc + u.pn * 256 + bj * 128 + wc * 32 + fq * 8; f32x4 v0 = acc[ai][bj][m][0], v1 = acc[ai][bj][m][1];
                    if (MODE <= 1) { const u32x4 g = *(const u32x4*)(gate + off);
                        v0[0] *= bflo(g.x); v0[1] *= bfhi(g.x); v0[2] *= bflo(g.y); v0[3] *= bfhi(g.y); v1[0] *= bflo(g.z); v1[1] *= bfhi(g.z); v1[2] *= bflo(g.w); v1[3] *= bfhi(g.w); }
                    if (MODE == 1) { const u32x4 t = *(const u32x4*)(add + off);
                        v0[0] += bflo(t.x); v0[1] += bfhi(t.x); v0[2] += bflo(t.y); v0[3] += bfhi(t.y); v1[0] += bflo(t.z); v1[1] += bfhi(t.z); v1[2] += bflo(t.w); v1[3] += bfhi(t.w); }
                    *(u32x4*)(dst + off) = pack8(v0, v1); } }
    }
};

struct EpiX1 {
    static constexpr bool PERM = false, AFTER_DRAIN = false;
    float* out; const float* x; const float* mod;
    __device__ __forceinline__ void operator()(const f32x4 (&acc)[2][2][4][2], const Unit& u, int wr, int wc, int fr, int fq) const {
        const int b = u.pm >> 4;
#pragma unroll
        for (int ai = 0; ai < 2; ++ai)
#pragma unroll
            for (int m = 0; m < 4; ++m) { const size_t row = (size_t)u.pm * 256 + ai * 128 + wr * 64 + m * 16 + fr;
#pragma unroll
                for (int bj = 0; bj < 2; ++bj)
#pragma unroll
                    for (int n = 0; n < 2; ++n) { const int col = u.pn * 256 + bj * 128 + wc * 32 + n * 16 + fq * 4;
                        const f32x4 g = *(const f32x4*)(mod + b * 6144 + 2048 + col), xv = *(const f32x4*)(x + row * 1024 + col);
                        *(f32x4*)(out + row * 1024 + col) = xv + g * acc[ai][bj][m][n]; } }
    }
};

struct Ctx { Params p; LAS unsigned char* lds; int tid, lane, wave, G, c; };

__device__ __forceinline__ bf16_t* wsb(const Params& p, size_t off) { return (bf16_t*)(p.ws + off); }
__device__ __forceinline__ float* wsf(const Params& p, size_t off) { return (float*)(p.ws + off); }

__device__ __forceinline__ void transpose_item(const float* W, int K, int N, bf16_t* WT, int item, LAS float* tile, int tid) {
    const int nblk = N / 64, kb = item / nblk, nb = item % nblk, k0 = kb * 64, n0 = nb * 64;
    __syncthreads();
#pragma unroll
    for (int i = 0; i < 8; ++i) { const int e = tid + 512 * i, kk = e >> 6, nn = e & 63; tile[kk * 65 + nn] = __builtin_nontemporal_load(W + (size_t)(k0 + kk) * N + n0 + nn); }
    __syncthreads();
    const int n = tid >> 3, cc = tid & 7; const LAS float* s = tile + (8 * cc) * 65 + n;
    u32x4 o; o.x = cvt_pk_bf16(s[0], s[65]); o.y = cvt_pk_bf16(s[130], s[195]); o.z = cvt_pk_bf16(s[260], s[325]); o.w = cvt_pk_bf16(s[390], s[455]);
    *(u32x4*)(WT + (size_t)(n0 + n) * K + k0 + 8 * cc) = o;
}

__device__ __forceinline__ void phase0(const Ctx& F) {
    const Params& p = F.p; const int tid = F.tid;
    LAS float* sil = (LAS float*)F.lds;
    LAS float* red = sil + 5 * 1024;
    LAS float* tile = red + 16 * 5 * 32;
    for (int i = tid; i < 5 * 1024; i += 512) { const float v = i < 4096 ? p.c[i] : p.c_ctx[i - 4096]; sil[i] = silu_(v); }
    __syncthreads();
    float* mod = wsf(p, OFF_MOD);
    constexpr int I_MOD = 192, I_WIN = 16 * 88, I_WOA = 8 * 16, I_WOL = 16 * 16, I_WOUT = 16 * 16, I_WPQ = 16 * 32, I_LRU = 32 * 4, I_KEYS = 64, I_ZERO = 68;
    constexpr int NITEMS = I_MOD + I_WIN + I_LRU + I_KEYS + I_ZERO;
    for (int it = F.c; it < NITEMS; it += F.G) {
        int r = it;
        if (r < I_MOD) {
            const int cl = tid & 31, kg = tid >> 5, col = r * 32 + cl; float a0 = 0, a1 = 0, a2 = 0, a3 = 0, a4 = 0;
#pragma unroll 32
            for (int kk = 0; kk < 64; ++kk) { const int k = kg * 64 + kk; const float w = __builtin_nontemporal_load(p.w_ada + (size_t)k * 6144 + col);
                a0 += sil[k] * w; a1 += sil[1024 + k] * w; a2 += sil[2048 + k] * w; a3 += sil[3072 + k] * w; a4 += sil[4096 + k] * w; }
            __syncthreads();
            red[(kg * 5 + 0) * 32 + cl] = a0; red[(kg * 5 + 1) * 32 + cl] = a1; red[(kg * 5 + 2) * 32 + cl] = a2; red[(kg * 5 + 3) * 32 + cl] = a3; red[(kg * 5 + 4) * 32 + cl] = a4;
            __syncthreads();
            if (tid < 160) { const int rr = tid >> 5, c2 = tid & 31; float s = 0; for (int g = 0; g < 16; ++g) s += red[(g * 5 + rr) * 32 + c2];
                mod[rr * 6144 + r * 32 + c2] = s + p.b_ada[r * 32 + c2]; }
            continue; }
        r -= I_MOD;
        if (r < I_WIN) { transpose_item(p.w_in, 1024, INC, wsb(p, OFF_WINT), r, tile, tid); continue; } r -= I_WIN;
        if (r < I_LRU) { const int mat = r >> 2, sub = r & 3;
            const int gate = mat >> 4, dn = mat & 15, dir = dn >> 3, n = dn & 7;
            const float* src = (gate ? p.lru_w_x : p.lru_w_a) + (size_t)dn * 128 * 128;
            transpose_item(src, 128, 128, wsb(p, OFF_LRUW) + (size_t)((dir * 2 + gate) * 8 + n) * 128 * 128, sub, tile, tid); continue; } r -= I_LRU;
        if (r < I_KEYS) { bf16_t* kd = wsb(p, OFF_KEYS); const int base = r * 4096 + tid * 8;
            const f32x4 a = *(const f32x4*)(p.peer_keys + base), b2 = *(const f32x4*)(p.peer_keys + base + 4);
            *(u32x4*)(kd + base) = pack8(a, b2); continue; } r -= I_KEYS;
        { float* z = wsf(p, OFF_QSS); const int base = r * 4096 + tid * 8;
            *(f32x4*)(z + base) = (f32x4){0.f, 0.f, 0.f, 0.f}; *(f32x4*)(z + base + 4) = (f32x4){0.f, 0.f, 0.f, 0.f}; }
    }
}
static_assert(OFF_KSS - OFF_QSS == (size_t)NB * 8 * SP * 4, "QSS/KSS contiguous");

__device__ __forceinline__ void norm_rows(const Ctx& F, const float* xlat, const float* xctx, int nrows, const float* nw, int shift_off, int scale_off, bf16_t* dst) {
    const float* mod = wsf(F.p, OFF_MOD);
    const int gw = F.c * 8 + F.wave, NGW = F.G * 8, lane = F.lane;
    f32x4 nv[4];
    if (gw < nrows) { const float* xr = gw < NT ? xlat + (size_t)gw * 1024 : xctx + (size_t)(gw - NT) * 1024;
#pragma unroll
        for (int j = 0; j < 4; ++j) nv[j] = *(const f32x4*)(xr + (lane + 64 * j) * 4); }
    for (int row = gw; row < nrows; row += NGW) {
        const int mb = row < NT ? (row >> 12) : 4;
        f32x4 v[4], w[4], sc[4], sh[4]; float s = 0.f;
#pragma unroll
        for (int j = 0; j < 4; ++j) { v[j] = nv[j]; s += v[j][0] * v[j][0] + v[j][1] * v[j][1] + v[j][2] * v[j][2] + v[j][3] * v[j][3]; }
        const int nrow = row + NGW;
        if (nrow < nrows) { const float* xr = nrow < NT ? xlat + (size_t)nrow * 1024 : xctx + (size_t)(nrow - NT) * 1024;
#pragma unroll
            for (int j = 0; j < 4; ++j) nv[j] = *(const f32x4*)(xr + (lane + 64 * j) * 4); }
#pragma unroll
        for (int j = 0; j < 4; ++j) { const int col = (lane + 64 * j) * 4; w[j] = *(const f32x4*)(nw + col); sc[j] = *(const f32x4*)(mod + mb * 6144 + scale_off + col); sh[j] = *(const f32x4*)(mod + mb * 6144 + shift_off + col); }
#pragma unroll
        for (int o = 1; o < 64; o <<= 1) s += __shfl_xor(s, o);
        const float rstd = rsqrtf(s * (1.f / 1024.f) + EPS);
#pragma unroll
        for (int j = 0; j < 4; ++j) { const int col = (lane + 64 * j) * 4;
            f32x4 h;
#pragma unroll
            for (int e = 0; e < 4; ++e) h[e] = v[j][e] * rstd * w[j][e] * (1.f + sc[j][e]) + sh[j][e];
            u32x2 o; o.x = cvt_pk_bf16(h[0], h[1]); o.y = cvt_pk_bf16(h[2], h[3]);
            *(u32x2*)(dst + (size_t)row * 1024 + col) = o; }
    }
}

__device__ __forceinline__ void attn_task(const Ctx& F, const LAS float* rpbs, int b, int r, int h, int qg) {
    const Params& p = F.p; const int lane = F.lane, fr = lane & 15, fq = lane >> 4;
    const bf16_t* Q = wsb(p, OFF_Q); const bf16_t* K = wsb(p, OFF_K); const bf16_t* VT = wsb(p, OFF_VT);
    const float* qss = wsf(p, OFF_QSS); const float* kss = wsf(p, OFF_KSS);
    const int tq = r * 64 + qg * 16 + fr, qc = qg * 16 + fr;
    const float LOG2E = 1.4426950408889634f;
    bf16x8 qf[2];
    { const float rq = rsqrtf(qss[(size_t)(b * 8 + h) * SP + tq] * (1.f / 64.f) + EPS) * 0.125f * LOG2E;
#pragma unroll
      for (int ks = 0; ks < 2; ++ks) { const int d0 = ks * 32 + fq * 8; const u32x4 raw = *(const u32x4*)(Q + (size_t)(b * SEQ + tq) * 512 + h * 64 + d0);
          const f32x4 wq0 = *(const f32x4*)(p.q_norm_w + d0), wq1 = *(const f32x4*)(p.q_norm_w + d0 + 4), wk0 = *(const f32x4*)(p.k_norm_w + d0), wk1 = *(const f32x4*)(p.k_norm_w + d0 + 4);
          f32x4 a, c2; a[0] = bflo(raw.x) * wq0[0] * wk0[0] * rq; a[1] = bfhi(raw.x) * wq0[1] * wk0[1] * rq; a[2] = bflo(raw.y) * wq0[2] * wk0[2] * rq; a[3] = bfhi(raw.y) * wq0[3] * wk0[3] * rq;
          c2[0] = bflo(raw.z) * wq1[0] * wk1[0] * rq; c2[1] = bfhi(raw.z) * wq1[1] * wk1[1] * rq; c2[2] = bflo(raw.w) * wq1[2] * wk1[2] * rq; c2[3] = bfhi(raw.w) * wq1[3] * wk1[3] * rq;
          const u32x4 pk = pack8(a, c2); qf[ks] = __builtin_bit_cast(bf16x8, pk); } }
    const int row0 = min(max(r - 4, 0), 56);
    const int nct = (qg == 0 || qg == 3) ? 2 : 3, ct0 = qg <= 1 ? 0 : qg - 1, nwin = 8 * nct, ntiles = nwin + 16;
    const int col0 = min(max(qc - 8, 0), 48);
    const size_t kbase = (size_t)b * SP * 512 + h * 64, ssbase = (size_t)(b * 8 + h) * SP, vbase = (size_t)(b * 8 + h) * 64 * SP;
    const LAS float* rp = rpbs + h * 465;
    f32x4 o[4]; for (int n = 0; n < 4; ++n) o[n] = (f32x4){0.f, 0.f, 0.f, 0.f};
    float mrun = -1e30f, lrun = 0.f;
    bf16x8 kA[4][2], kB[4][2]; f32x4 ssA[4], ssB[4]; int krA[4], ctA[4], krB[4], ctB[4], tbA[4], tbB[4];
#define ATT_LOAD(t0_, kk, ssx, tbx, krx, ctx) do { \
        _Pragma("unroll") for (int u = 0; u < 4; ++u) { const int ti = (t0_) + u; int tokb_; \
            if (ti < nwin) { krx[u] = row0 + ti / nct; ctx[u] = ct0 + ti % nct; tokb_ = krx[u] * 64 + ctx[u] * 16; } else { krx[u] = -1; ctx[u] = 0; tokb_ = 4096 + (ti - nwin) * 16; } \
            const bf16_t* kp = K + kbase + (size_t)(tokb_ + fr) * 512 + fq * 8; \
            kk[u][0] = *(const bf16x8*)kp; kk[u][1] = *(const bf16x8*)(kp + 32); \
            ssx[u] = *(const f32x4*)(kss + ssbase + tokb_ + 4 * fq); tbx[u] = tokb_; } } while (0)
#define ATT_COMPUTE(kk, ssx, tbx, krx, ctx) do { \
        u32x2 vv[4][4]; \
        _Pragma("unroll") for (int u = 0; u < 4; ++u) _Pragma("unroll") for (int n = 0; n < 4; ++n) vv[u][n] = *(const u32x2*)(VT + vbase + (size_t)(16 * n + fr) * SP + 4 * fq + tbx[u]); \
        f32x4 s[4]; \
        _Pragma("unroll") for (int u = 0; u < 4; ++u) { f32x4 a = (f32x4){0.f, 0.f, 0.f, 0.f}; \
            a = __builtin_amdgcn_mfma_f32_16x16x32_bf16(kk[u][0], qf[0], a, 0, 0, 0); \
            a = __builtin_amdgcn_mfma_f32_16x16x32_bf16(kk[u][1], qf[1], a, 0, 0, 0); \
            const bool win = krx[u] >= 0; \
            _Pragma("unroll") for (int j = 0; j < 4; ++j) { float v = a[j] * rsqrtf(ssx[u][j] * (1.f / 64.f) + EPS); \
                if (win) { const int kc = ctx[u] * 16 + 4 * fq + j; const int dc = min(max(kc - qc, -15), 15); \
                    const float bias = rp[(krx[u] - r + 7) * 31 + dc + 15]; \
                    v = (kc >= col0 && kc < col0 + 16) ? v + bias : -3.0e38f; } \
                a[j] = v; } \
            s[u] = a; } \
        float cm = s[0][0]; \
        _Pragma("unroll") for (int u = 0; u < 4; ++u) _Pragma("unroll") for (int j = 0; j < 4; ++j) cm = fmaxf(cm, s[u][j]); \
        cm = fmaxf(cm, __shfl_xor(cm, 16)); cm = fmaxf(cm, __shfl_xor(cm, 32)); \
        const float mnew = fmaxf(mrun, cm), alpha = __builtin_amdgcn_exp2f(mrun - mnew); mrun = mnew; \
        float ps = 0.f; \
        _Pragma("unroll") for (int u = 0; u < 4; ++u) _Pragma("unroll") for (int j = 0; j < 4; ++j) { s[u][j] = __builtin_amdgcn_exp2f(s[u][j] - mnew); ps += s[u][j]; } \
        lrun = lrun * alpha + ps; \
        _Pragma("unroll") for (int n = 0; n < 4; ++n) o[n] = o[n] * alpha; \
        _Pragma("unroll") for (int pr = 0; pr < 2; ++pr) { const u32x4 pk = pack8(s[2 * pr], s[2 * pr + 1]); const bf16x8 pf = __builtin_bit_cast(bf16x8, pk); \
            _Pragma("unroll") for (int n = 0; n < 4; ++n) { u32x4 vw; vw.x = vv[2 * pr][n].x; vw.y = vv[2 * pr][n].y; vw.z = vv[2 * pr + 1][n].x; vw.w = vv[2 * pr + 1][n].y; \
                o[n] = __builtin_amdgcn_mfma_f32_16x16x32_bf16(__builtin_bit_cast(bf16x8, vw), pf, o[n], 0, 0, 0); } } } while (0)
    ATT_LOAD(0, kA, ssA, tbA, krA, ctA);
    for (int t0 = 0; t0 < ntiles; t0 += 8) {
        ATT_LOAD(t0 + 4, kB, ssB, tbB, krB, ctB);
        __builtin_amdgcn_sched_barrier(0);
        ATT_COMPUTE(kA, ssA, tbA, krA, ctA);
        if (t0 + 8 < ntiles) ATT_LOAD(t0 + 8, kA, ssA, tbA, krA, ctA);
        __builtin_amdgcn_sched_barrier(0);
        ATT_COMPUTE(kB, ssB, tbB, krB, ctB);
    }
#undef ATT_LOAD
#undef ATT_COMPUTE
    lrun += __shfl_xor(lrun, 16); lrun += __shfl_xor(lrun, 32);
    const float inv = 1.f / lrun;
    bf16_t* op = wsb(p, OFF_OA) + (size_t)(b * SEQ + tq) * 512 + h * 64 + 4 * fq;
#pragma unroll
    for (int n = 0; n < 4; ++n) { u32x2 w; w.x = cvt_pk_bf16(o[n][0] * inv, o[n][1] * inv); w.y = cvt_pk_bf16(o[n][2] * inv, o[n][3] * inv); *(u32x2*)(op + 16 * n) = w; }
}


struct AttnPre { u32x4 kreg[2], vreg[2]; f32x4 sreg; u32x4 qraw[2]; float qssv; };
__device__ __forceinline__ void attn_prefetch(const Ctx& F, int b, int r, int hp, AttnPre& P) {
    const Params& p = F.p; const int tid = F.tid, lane = F.lane, fr = lane & 15, fq = lane >> 4, hh = F.wave >> 2, qg = F.wave & 3, h = hp * 2 + hh;
    const int tq = r * 64 + qg * 16 + fr, row0 = min(max(r - 4, 0), 56), tok0 = row0 * 64;
    const int lh = tid >> 8, idx = tid & 255, lhead = hp * 2 + lh;
    const bf16_t* kg = wsb(p, OFF_K) + (size_t)b * SP * 512 + lhead * 64; const bf16_t* vg = wsb(p, OFF_VT) + (size_t)(b * 8 + lhead) * 64 * SP; const float* sg = wsf(p, OFF_KSS) + (size_t)(b * 8 + lhead) * SP;
#pragma unroll
    for (int pp = 0; pp < 2; ++pp) { const int e = idx + 256 * pp, rowi = e >> 3, piece = e & 7;
        P.kreg[pp] = *(const u32x4*)(kg + (size_t)(tok0 + rowi) * 512 + piece * 8); P.vreg[pp] = *(const u32x4*)(vg + (size_t)rowi * SP + tok0 + piece * 8); }
    P.sreg = (f32x4){0.f, 0.f, 0.f, 0.f}; if (idx < 16) P.sreg = *(const f32x4*)(sg + tok0 + idx * 4);
#pragma unroll
    for (int ks = 0; ks < 2; ++ks) P.qraw[ks] = *(const u32x4*)(wsb(p, OFF_Q) + (size_t)(b * SEQ + tq) * 512 + h * 64 + ks * 32 + fq * 8);
    P.qssv = wsf(p, OFF_QSS)[(size_t)(b * 8 + h) * SP + tq];
}
__device__ __forceinline__ void attn_item(const Ctx& F, const LAS float* rpbs, int b, int r, int hp, AttnPre& P, bool has_next, int nb, int nr, int nhp) {
    const Params& p = F.p; const int tid = F.tid, lane = F.lane, fr = lane & 15, fq = lane >> 4, hh = F.wave >> 2, qg = F.wave & 3, h = hp * 2 + hh;
    const bf16_t* Q = wsb(p, OFF_Q); const bf16_t* K = wsb(p, OFF_K); const bf16_t* VT = wsb(p, OFF_VT);
    const float* qss = wsf(p, OFF_QSS); const float* kss = wsf(p, OFF_KSS);
    constexpr int KSTR = 72, BUFB = 2 * 64 * KSTR * 2 * 2 + 512;
    const int tq = r * 64 + qg * 16 + fr, qc = qg * 16 + fr;
    const float LOG2E = 1.4426950408889634f;
    bf16x8 qf[2];
    { const float rq = rsqrtf(P.qssv * (1.f / 64.f) + EPS) * 0.125f * LOG2E;
#pragma unroll
      for (int ks = 0; ks < 2; ++ks) { const int d0 = ks * 32 + fq * 8; const u32x4 raw = P.qraw[ks];
          const f32x4 wq0 = *(const f32x4*)(p.q_norm_w + d0), wq1 = *(const f32x4*)(p.q_norm_w + d0 + 4), wk0 = *(const f32x4*)(p.k_norm_w + d0), wk1 = *(const f32x4*)(p.k_norm_w + d0 + 4);
          f32x4 a, c2; a[0] = bflo(raw.x) * wq0[0] * wk0[0] * rq; a[1] = bfhi(raw.x) * wq0[1] * wk0[1] * rq; a[2] = bflo(raw.y) * wq0[2] * wk0[2] * rq; a[3] = bfhi(raw.y) * wq0[3] * wk0[3] * rq;
          c2[0] = bflo(raw.z) * wq1[0] * wk1[0] * rq; c2[1] = bfhi(raw.z) * wq1[1] * wk1[1] * rq; c2[2] = bflo(raw.w) * wq1[2] * wk1[2] * rq; c2[3] = bfhi(raw.w) * wq1[3] * wk1[3] * rq;
          const u32x4 pk = pack8(a, c2); qf[ks] = __builtin_bit_cast(bf16x8, pk); } }
    const int row0 = min(max(r - 4, 0), 56), col0 = min(max(qc - 8, 0), 48);
    const LAS float* rp = rpbs + h * 480; const float negM = -rpbs[8 * 15 * 32 + h];
    int boff[4][4];
#pragma unroll
    for (int ct = 0; ct < 4; ++ct)
#pragma unroll
        for (int j = 0; j < 4; ++j) { const int kc = ct * 16 + 4 * fq + j; const int dc = min(max(kc - qc, -15), 15); boff[ct][j] = (kc >= col0 && kc < col0 + 16) ? dc + 15 : 31; }
    const int lh = tid >> 8, idx = tid & 255, lhead = hp * 2 + lh;
    const bf16_t* kg = K + (size_t)b * SP * 512 + lhead * 64; const bf16_t* vg = VT + (size_t)(b * 8 + lhead) * 64 * SP; const float* sg = kss + (size_t)(b * 8 + lhead) * SP;
    u32x4 kreg[2], vreg[2]; f32x4 sreg = P.sreg; kreg[0] = P.kreg[0]; kreg[1] = P.kreg[1]; vreg[0] = P.vreg[0]; vreg[1] = P.vreg[1];
#define AT_ISSUE(c_) do { const int tok0_ = (c_) < 8 ? (row0 + (c_)) * 64 : 4096 + ((c_) - 8) * 64; \
        _Pragma("unroll") for (int pp = 0; pp < 2; ++pp) { const int e = idx + 256 * pp, rowi = e >> 3, piece = e & 7; \
            kreg[pp] = *(const u32x4*)(kg + (size_t)(tok0_ + rowi) * 512 + piece * 8); vreg[pp] = *(const u32x4*)(vg + (size_t)rowi * SP + tok0_ + piece * 8); } \
        if (idx < 16) sreg = *(const f32x4*)(sg + tok0_ + idx * 4); } while (0)
#define AT_WRITE(bi_) do { LAS unsigned char* bb_ = F.lds + (bi_) * BUFB; \
        _Pragma("unroll") for (int pp = 0; pp < 2; ++pp) { const int e = idx + 256 * pp, rowi = e >> 3, piece = e & 7; \
            *(LAS u32x4*)(bb_ + ((lh * 64 + rowi) * KSTR + piece * 8) * 2) = kreg[pp]; *(LAS u32x4*)(bb_ + 2 * 64 * KSTR * 2 + ((lh * 64 + rowi) * KSTR + piece * 8) * 2) = vreg[pp]; } \
        if (idx < 16) { f32x4 rk_; _Pragma("unroll") for (int j_ = 0; j_ < 4; ++j_) rk_[j_] = rsqrtf(sreg[j_] * (1.f / 64.f) + EPS); *(LAS f32x4*)(bb_ + 4 * 64 * KSTR * 2 + (lh * 64 + idx * 4) * 4) = rk_; } } while (0)
    f32x4 o[4]; for (int n = 0; n < 4; ++n) o[n] = (f32x4){0.f, 0.f, 0.f, 0.f};
    float lrun = 0.f;
    __syncthreads();
    AT_WRITE(0);
    __syncthreads();
    for (int c = 0; c < 12; ++c) {
        if (c + 1 < 12) AT_ISSUE(c + 1); else if (has_next) attn_prefetch(F, nb, nr, nhp, P);
        const LAS unsigned char* bb = F.lds + (c & 1) * BUFB;
        const LAS bf16_t* Kl = (const LAS bf16_t*)bb + hh * 64 * KSTR; const LAS bf16_t* Vl = (const LAS bf16_t*)(bb + 2 * 64 * KSTR * 2) + hh * 64 * KSTR;
        const LAS float* sl = (const LAS float*)(bb + 4 * 64 * KSTR * 2) + hh * 64;
        const bool win = c < 8; const int kr = row0 + c; const LAS float* rprow = rp + (win ? (kr - r + 7) * 32 : 0);
#pragma unroll
        for (int pr = 0; pr < 2; ++pr) {
            if (win && (pr == 0 ? qg == 3 : qg == 0)) continue;
            f32x4 s[2];
#pragma unroll
            for (int u = 0; u < 2; ++u) { const int ct = pr * 2 + u;
                const bf16x8 k0 = *(const LAS bf16x8*)(Kl + (ct * 16 + fr) * KSTR + fq * 8), k1 = *(const LAS bf16x8*)(Kl + (ct * 16 + fr) * KSTR + 32 + fq * 8);
                f32x4 a = (f32x4){0.f, 0.f, 0.f, 0.f};
                a = __builtin_amdgcn_mfma_f32_16x16x32_bf16(k0, qf[0], a, 0, 0, 0);
                a = __builtin_amdgcn_mfma_f32_16x16x32_bf16(k1, qf[1], a, 0, 0, 0);
                const f32x4 ss = *(const LAS f32x4*)(sl + ct * 16 + 4 * fq);
                if (win) {
#pragma unroll
                    for (int j = 0; j < 4; ++j) a[j] = a[j] * ss[j] + rprow[boff[ct][j]]; }
                else {
#pragma unroll
                    for (int j = 0; j < 4; ++j) a[j] = a[j] * ss[j] + negM; }
                s[u] = a; }
            float ps = 0.f;
#pragma unroll
            for (int u = 0; u < 2; ++u)
#pragma unroll
                for (int j = 0; j < 4; ++j) { s[u][j] = __builtin_amdgcn_exp2f(s[u][j]); ps += s[u][j]; }
            lrun += ps;
            const u32x4 pk = pack8(s[0], s[1]); const bf16x8 pf = __builtin_bit_cast(bf16x8, pk);
#pragma unroll
            for (int n = 0; n < 4; ++n) { const LAS bf16_t* vp = Vl + (16 * n + fr) * KSTR + pr * 32 + 4 * fq;
                const u32x2 v0 = *(const LAS u32x2*)vp, v1 = *(const LAS u32x2*)(vp + 16);
                u32x4 vw; vw.x = v0.x; vw.y = v0.y; vw.z = v1.x; vw.w = v1.y;
                o[n] = __builtin_amdgcn_mfma_f32_16x16x32_bf16(__builtin_bit_cast(bf16x8, vw), pf, o[n], 0, 0, 0); } }
        if (c + 1 < 12) AT_WRITE((c + 1) & 1);
        __syncthreads();
    }
#undef AT_ISSUE
#undef AT_WRITE
    lrun += __shfl_xor(lrun, 16); lrun += __shfl_xor(lrun, 32);
    const float inv = 1.f / lrun;
    bf16_t* op = wsb(p, OFF_OA) + (size_t)(b * SEQ + tq) * 512 + h * 64 + 4 * fq;
#pragma unroll
    for (int n = 0; n < 4; ++n) { u32x2 w; w.x = cvt_pk_bf16(o[n][0] * inv, o[n][1] * inv); w.y = cvt_pk_bf16(o[n][2] * inv, o[n][3] * inv); *(u32x2*)(op + 16 * n) = w; }
}

struct LruConst { bf16x8 wfr[4][4]; float ba0, bx0, ba1, bx1, la0, la1, w0[4], w1[4], cb0, cb1; int n; };
__device__ __forceinline__ void lru_load_const(const Ctx& F, int n, LruConst& C) {
    const Params& p = F.p; const int tid = F.tid, lane = F.lane, w = F.wave, fr = lane & 15, fq = lane >> 4;
    const bf16_t* LW = wsb(p, OFF_LRUW);
#pragma unroll
    for (int g = 0; g < 4; ++g)
#pragma unroll
        for (int ks = 0; ks < 4; ++ks) C.wfr[g][ks] = *(const bf16x8*)(LW + ((size_t)(g * 8 + n) * 128 + 16 * w + fr) * 128 + ks * 32 + fq * 8);
    const int ch = n * 128 + 16 * w + fr;
    C.ba0 = p.lru_b_a[ch]; C.bx0 = p.lru_b_x[ch]; C.ba1 = p.lru_b_a[1024 + ch]; C.bx1 = p.lru_b_x[1024 + ch];
    C.la0 = -8.f * log1pf(__expf(-p.lru_lambda[ch])); C.la1 = -8.f * log1pf(__expf(-p.lru_lambda[1024 + ch]));
    const int ch2 = n * 128 + 2 * (tid & 63);
#pragma unroll
    for (int j = 0; j < 4; ++j) { C.w0[j] = p.conv_w[j * 1024 + ch2]; C.w1[j] = p.conv_w[j * 1024 + ch2 + 1]; }
    C.cb0 = p.conv_b[ch2]; C.cb1 = p.conv_b[ch2 + 1]; C.n = n;
}
__device__ __forceinline__ void lru_load_x(const Ctx& F, int b, int ci, int n, unsigned (&xraw)[11]) {
    const int tid = F.tid; const bool lat = ci < 64; const int T = lat ? SEQ : CTX, t0 = lat ? ci * 64 : (ci - 64) * 64;
    const size_t rowbase = lat ? (size_t)b * SEQ : (size_t)NT + (size_t)b * CTX;
    const bf16_t* XR = wsb(F.p, OFF_XR); const int c2 = tid & 63, tg = tid >> 6, ch = n * 128 + 2 * c2;
#pragma unroll
    for (int i = 0; i < 11; ++i) { const int t = t0 + tg * 8 - 2 + i; unsigned raw = 0u; if (t >= 0 && t < T) raw = *(const unsigned*)(XR + (rowbase + t) * 1024 + ch); xraw[i] = raw; }
}
constexpr int LRU_BUF = 64 * 136 * 2 + 64 * 129 * 4;
__device__ __forceinline__ void lru_conv_to_lds(const Ctx& F, const LruConst& C, const unsigned (&xraw)[11], int buf) {
    const int tid = F.tid; LAS bf16_t* Ub = (LAS bf16_t*)(F.lds + buf * LRU_BUF); LAS float* Uf = (LAS float*)(F.lds + buf * LRU_BUF + 64 * 136 * 2);
    const int c2 = tid & 63, tg = tid >> 6;
#pragma unroll
    for (int tt = 0; tt < 8; ++tt) { const float u0 = C.cb0 + C.w0[0] * bflo(xraw[tt]) + C.w0[1] * bflo(xraw[tt + 1]) + C.w0[2] * bflo(xraw[tt + 2]) + C.w0[3] * bflo(xraw[tt + 3]);
        const float u1 = C.cb1 + C.w1[0] * bfhi(xraw[tt]) + C.w1[1] * bfhi(xraw[tt + 1]) + C.w1[2] * bfhi(xraw[tt + 2]) + C.w1[3] * bfhi(xraw[tt + 3]);
        const int tl = tg * 8 + tt; Uf[tl * 129 + 2 * c2] = u0; Uf[tl * 129 + 2 * c2 + 1] = u1; *(LAS unsigned*)(Ub + tl * 136 + 2 * c2) = cvt_pk_bf16(u0, u1); }
}
__device__ __forceinline__ void lru_gates(const Ctx& F, const LruConst& C, int buf, float (&af)[4][4], float (&bfw)[4][4], float (&ab)[4][4], float (&bb)[4][4]) {
    const int lane = F.lane, w = F.wave, fr = lane & 15, fq = lane >> 4;
    const LAS bf16_t* Ub = (const LAS bf16_t*)(F.lds + buf * LRU_BUF); const LAS float* Uf = (const LAS float*)(F.lds + buf * LRU_BUF + 64 * 136 * 2);
    f32x4 acc[4][4];
#pragma unroll
    for (int g = 0; g < 4; ++g)
#pragma unroll
        for (int tt = 0; tt < 4; ++tt) acc[g][tt] = (f32x4){0.f, 0.f, 0.f, 0.f};
#pragma unroll
    for (int ks = 0; ks < 4; ++ks) { bf16x8 afr[4];
#pragma unroll
        for (int tt = 0; tt < 4; ++tt) afr[tt] = *(const LAS bf16x8*)(Ub + (16 * tt + fr) * 136 + ks * 32 + fq * 8);
#pragma unroll
        for (int g = 0; g < 4; ++g)
#pragma unroll
            for (int tt = 0; tt < 4; ++tt) acc[g][tt] = __builtin_amdgcn_mfma_f32_16x16x32_bf16(afr[tt], C.wfr[g][ks], acc[g][tt], 0, 0, 0); }
#pragma unroll
    for (int tt = 0; tt < 4; ++tt)
#pragma unroll
        for (int j = 0; j < 4; ++j) { const float u = Uf[(16 * tt + 4 * fq + j) * 129 + 16 * w + fr];
            { const float rg = sigmoidf_(acc[0][tt][j] + C.ba0), ig = sigmoidf_(acc[1][tt][j] + C.bx0); const float a = __expf(rg * C.la0); af[tt][j] = rg; bfw[tt][j] = sqrtf(fmaxf(1.f - a * a, 0.f)) * ig * u; }
            { const float rg = sigmoidf_(acc[2][tt][j] + C.ba1), ig = sigmoidf_(acc[3][tt][j] + C.bx1); const float a = __expf(rg * C.la1); ab[tt][j] = rg; bb[tt][j] = sqrtf(fmaxf(1.f - a * a, 0.f)) * ig * u; } }
}
__device__ __forceinline__ float clamp_e4m3(float v) { return __builtin_amdgcn_fmed3f(v, -448.f, 448.f); }
__device__ __forceinline__ unsigned q4_fp8(float v0, float v1, float v2, float v3, float sc) { int w = 0; w = __builtin_amdgcn_cvt_pk_fp8_f32(clamp_e4m3(v0 * sc), clamp_e4m3(v1 * sc), w, false); w = __builtin_amdgcn_cvt_pk_fp8_f32(clamp_e4m3(v2 * sc), clamp_e4m3(v3 * sc), w, true); return (unsigned)w; }
__device__ __forceinline__ void lru_decode(const u32x4& rf, const u32x4& rb, const u32x4& bf8, const u32x4& bb8, float la0, float la1, float (&af)[4][4], float (&bfw)[4][4], float (&ab)[4][4], float (&bb)[4][4]) {
#pragma unroll
    for (int tt = 0; tt < 4; ++tt) {
        { const f32x2 lo = __builtin_amdgcn_cvt_pk_f32_fp8((int)rf[tt], false), hi = __builtin_amdgcn_cvt_pk_f32_fp8((int)rf[tt], true); const float k = la0 * (1.f / 256.f);
          af[tt][0] = __expf(lo.x * k); af[tt][1] = __expf(lo.y * k); af[tt][2] = __expf(hi.x * k); af[tt][3] = __expf(hi.y * k); }
        { const f32x2 lo = __builtin_amdgcn_cvt_pk_f32_fp8((int)rb[tt], false), hi = __builtin_amdgcn_cvt_pk_f32_fp8((int)rb[tt], true); const float k = la1 * (1.f / 256.f);
          ab[tt][0] = __expf(lo.x * k); ab[tt][1] = __expf(lo.y * k); ab[tt][2] = __expf(hi.x * k); ab[tt][3] = __expf(hi.y * k); }
        { const f32x2 lo = __builtin_amdgcn_cvt_pk_f32_fp8((int)bf8[tt], false), hi = __builtin_amdgcn_cvt_pk_f32_fp8((int)bf8[tt], true);
          bfw[tt][0] = lo.x * (1.f / 64.f); bfw[tt][1] = lo.y * (1.f / 64.f); bfw[tt][2] = hi.x * (1.f / 64.f); bfw[tt][3] = hi.y * (1.f / 64.f); }
        { const f32x2 lo = __builtin_amdgcn_cvt_pk_f32_fp8((int)bb8[tt], false), hi = __builtin_amdgcn_cvt_pk_f32_fp8((int)bb8[tt], true);
          bb[tt][0] = lo.x * (1.f / 64.f); bb[tt][1] = lo.y * (1.f / 64.f); bb[tt][2] = hi.x * (1.f / 64.f); bb[tt][3] = hi.y * (1.f / 64.f); } }
}

__device__ __forceinline__ void lru_summary_item(const Ctx& F, const LruConst& C, int item, int buf) {
    const int n = item & 7, ci = (item >> 3) % 68, b = (item >> 3) / 68; const int lane = F.lane, fr = lane & 15, fq = lane >> 4;
    float af[4][4], bfw[4][4], ab[4][4], bb[4][4]; const float la0 = C.la0, la1 = C.la1;
    lru_gates(F, C, buf, af, bfw, ab, bb);
    { u32x4 rf, rb, bf8, bb8;
#pragma unroll
      for (int tt = 0; tt < 4; ++tt) { rf[tt] = q4_fp8(af[tt][0], af[tt][1], af[tt][2], af[tt][3], 256.f); rb[tt] = q4_fp8(ab[tt][0], ab[tt][1], ab[tt][2], ab[tt][3], 256.f);
          bf8[tt] = q4_fp8(bfw[tt][0], bfw[tt][1], bfw[tt][2], bfw[tt][3], 64.f); bb8[tt] = q4_fp8(bb[tt][0], bb[tt][1], bb[tt][2], bb[tt][3], 64.f); }
      if (ci < 64) { u32x4* d = (u32x4*)(F.p.ws + OFF_LRD) + ((size_t)((b * 64 + ci) * 8 + n) * 4) * 512 + F.tid; d[0] = rf; d[512] = rb; d[1024] = bf8; d[1536] = bb8; }
      lru_decode(rf, rb, bf8, bb8, la0, la1, af, bfw, ab, bb); }
    float At = 1.f, Bt = 0.f;
#pragma unroll
    for (int tt = 0; tt < 4; ++tt) { float A = 1.f, B = 0.f;
#pragma unroll
        for (int j = 0; j < 4; ++j) { B = af[tt][j] * B + bfw[tt][j]; A = af[tt][j] * A; }
        { const float pA = __shfl_xor(A, 16), pB = __shfl_xor(B, 16); if ((fq & 1) == 0) { B = pA * B + pB; A = pA * A; } else { B = A * pB + B; A = A * pA; } }
        { const float pA = __shfl_xor(A, 32), pB = __shfl_xor(B, 32); if ((fq & 2) == 0) { B = pA * B + pB; A = pA * A; } else { B = A * pB + B; A = A * pA; } }
        Bt = A * Bt + B; At = A * At; }
    float Ar = 1.f, Br = 0.f;
#pragma unroll
    for (int tt = 3; tt >= 0; --tt) { float A = 1.f, B = 0.f;
#pragma unroll
        for (int j = 3; j >= 0; --j) { B = ab[tt][j] * B + bb[tt][j]; A = ab[tt][j] * A; }
        { const float pA = __shfl_xor(A, 16), pB = __shfl_xor(B, 16); if ((fq & 1) != 0) { B = pA * B + pB; A = pA * A; } else { B = A * pB + B; A = A * pA; } }
        { const float pA = __shfl_xor(A, 32), pB = __shfl_xor(B, 32); if ((fq & 2) != 0) { B = pA * B + pB; A = pA * A; } else { B = A * pB + B; A = A * pA; } }
        Br = A * Br + B; Ar = A * Ar; }
    if (fq == 0) { float* chk = wsf(F.p, OFF_CHK) + (size_t)(b * 68 + ci) * 4096 + n * 128 + 16 * F.wave + fr;
        chk[0] = At; chk[1024] = Bt; chk[2048] = Ar; chk[3072] = Br; }
}

__device__ __forceinline__ void lru_final_run(const Ctx& F, int run) {
    const Params& p = F.p; const int tid = F.tid, lane = F.lane, w = F.wave, fr = lane & 15, fq = lane >> 4;
    const int n = run & 7, r8 = (run >> 3) & 7, b = run >> 6;
    LAS float* carry = (LAS float*)(F.lds + 65536);
    __syncthreads();
    if (tid < 256) { const int dir = tid >> 7, cl = tid & 127; const float* chk = wsf(p, OFF_CHK) + (size_t)b * 68 * 4096 + dir * 2048 + n * 128 + cl;
        const int nsteps = dir == 0 ? 4 + r8 * 8 + 7 : 67 - r8 * 8; float h = 0.f;
        for (int s0 = 0; s0 <= nsteps; s0 += 8) { float A[8], Bv[8]; int cc[8];
#pragma unroll
            for (int u = 0; u < 8; ++u) { const int s = s0 + u; int cidx = dir == 0 ? (s < 4 ? 64 + s : s - 4) : 67 - s; cidx = min(max(cidx, 0), 67); cc[u] = cidx; A[u] = chk[(size_t)cidx * 4096]; Bv[u] = chk[(size_t)cidx * 4096 + 1024]; }
#pragma unroll
            for (int u = 0; u < 8; ++u) { const int s = s0 + u; if (s <= nsteps) { const int k = cc[u] - r8 * 8; if (k >= 0 && k < 8) carry[(dir * 8 + k) * 128 + cl] = h; if (s < nsteps) h = A[u] * h + Bv[u]; } } } }
    const bf16_t* YG = wsb(p, OFF_YG); bf16_t* OB = wsb(p, OFF_HBUF);
    LAS bf16_t* T = (LAS bf16_t*)F.lds;
    const int ch = n * 128 + 16 * w + fr;
    const float la0 = -8.f * log1pf(__expf(-p.lru_lambda[ch])), la1 = -8.f * log1pf(__expf(-p.lru_lambda[1024 + ch]));
    __syncthreads();
    u32x4 nrf, nrb, nbf, nbb, nyg0, nyg1;
    { const u32x4* d = (const u32x4*)(p.ws + OFF_LRD) + ((size_t)((b * 64 + r8 * 8) * 8 + n) * 4) * 512 + tid; nrf = __builtin_nontemporal_load(d); nrb = __builtin_nontemporal_load(d + 512); nbf = __builtin_nontemporal_load(d + 1024); nbb = __builtin_nontemporal_load(d + 1536);
      const size_t o0 = (size_t)(b * SEQ + r8 * 8 * 64 + (tid >> 3)) * 1024 + n * 128 + 16 * (tid & 7); nyg0 = *(const u32x4*)(YG + o0); nyg1 = *(const u32x4*)(YG + o0 + 8); }
    for (int k = 0; k < 8; ++k) { const int ci = r8 * 8 + k;
        float af[4][4], bfw[4][4], ab[4][4], bb[4][4];
        lru_decode(nrf, nrb, nbf, nbb, la0, la1, af, bfw, ab, bb);
        const size_t orow = (size_t)(b * SEQ + ci * 64 + (tid >> 3)) * 1024 + n * 128 + 16 * (tid & 7);
        const u32x4 yg0 = nyg0, yg1 = nyg1;
        if (k < 7) { const u32x4* d = (const u32x4*)(p.ws + OFF_LRD) + ((size_t)((b * 64 + ci + 1) * 8 + n) * 4) * 512 + tid; nrf = __builtin_nontemporal_load(d); nrb = __builtin_nontemporal_load(d + 512); nbf = __builtin_nontemporal_load(d + 1024); nbb = __builtin_nontemporal_load(d + 1536);
            nyg0 = *(const u32x4*)(YG + orow + 64 * 1024); nyg1 = *(const u32x4*)(YG + orow + 64 * 1024 + 8); }
        float hs = carry[(0 * 8 + k) * 128 + 16 * w + fr];
#pragma unroll
        for (int tt = 0; tt < 4; ++tt) { float A = 1.f, B = 0.f;
#pragma unroll
            for (int j = 0; j < 4; ++j) { B = af[tt][j] * B + bfw[tt][j]; A = af[tt][j] * A; }
            float PA[4], PB[4];
#pragma unroll
            for (int q = 0; q < 4; ++q) { PA[q] = __shfl(A, fr + 16 * q); PB[q] = __shfl(B, fr + 16 * q); }
            float e = hs;
#pragma unroll
            for (int q = 0; q < 3; ++q) if (q < fq) e = PA[q] * e + PB[q];
#pragma unroll
            for (int q = 0; q < 4; ++q) hs = PA[q] * hs + PB[q];
#pragma unroll
            for (int j = 0; j < 4; ++j) { e = af[tt][j] * e + bfw[tt][j]; af[tt][j] = e; } }
        hs = carry[(1 * 8 + k) * 128 + 16 * w + fr];
#pragma unroll
        for (int tt = 3; tt >= 0; --tt) { float A = 1.f, B = 0.f;
#pragma unroll
            for (int j = 3; j >= 0; --j) { B = ab[tt][j] * B + bb[tt][j]; A = ab[tt][j] * A; }
            float PA[4], PB[4];
#pragma unroll
            for (int q = 0; q < 4; ++q) { PA[q] = __shfl(A, fr + 16 * q); PB[q] = __shfl(B, fr + 16 * q); }
            float e = hs;
#pragma unroll
            for (int q = 3; q > 0; --q) if (q > fq) e = PA[q] * e + PB[q];
#pragma unroll
            for (int q = 3; q >= 0; --q) hs = PA[q] * hs + PB[q];
#pragma unroll
            for (int j = 3; j >= 0; --j) { e = ab[tt][j] * e + bb[tt][j]; af[tt][j] += e; } }
        __syncthreads();
#pragma unroll
        for (int tt = 0; tt < 4; ++tt)
#pragma unroll
            for (int j = 0; j < 4; j += 2) { const unsigned pk = cvt_pk_bf16(af[tt][j], af[tt][j + 1]);
                T[(16 * tt + 4 * fq + j) * 136 + 16 * w + fr] = (bf16_t)(pk & 0xffff); T[(16 * tt + 4 * fq + j + 1) * 136 + 16 * w + fr] = (bf16_t)(pk >> 16); }
        __syncthreads();
        { const LAS bf16_t* tp = T + (tid >> 3) * 136 + 16 * (tid & 7); const u32x4 h0 = *(const LAS u32x4*)tp, h1 = *(const LAS u32x4*)(tp + 8);
          u32x4 o0, o1;
#pragma unroll
          for (int q = 0; q < 4; ++q) { o0[q] = cvt_pk_bf16(bflo(h0[q]) * bflo(yg0[q]), bfhi(h0[q]) * bfhi(yg0[q])); o1[q] = cvt_pk_bf16(bflo(h1[q]) * bflo(yg1[q]), bfhi(h1[q]) * bfhi(yg1[q])); }
          *(u32x4*)(OB + orow) = o0; *(u32x4*)(OB + orow + 8) = o1; }
    }
}

template <int N> __device__ __forceinline__ void bitonic_sort_desc(unsigned (&v)[N]) {
#pragma unroll
    for (int k = 2; k <= N; k <<= 1)
#pragma unroll
        for (int j = k >> 1; j > 0; j >>= 1)
#pragma unroll
            for (int i = 0; i < N; ++i) { const int l = i ^ j; if (l > i) { const unsigned a = v[i], b2 = v[l]; const unsigned mx = a > b2 ? a : b2, mn = a > b2 ? b2 : a;
                    if ((i & k) == 0) { v[i] = mx; v[l] = mn; } else { v[i] = mn; v[l] = mx; } } }
}
__device__ __forceinline__ void merge_top16(unsigned (&a)[16], const unsigned (&b)[16]) {
#pragma unroll
    for (int i = 0; i < 16; ++i) a[i] = a[i] > b[15 - i] ? a[i] : b[15 - i];
#pragma unroll
    for (int j = 8; j > 0; j >>= 1)
#pragma unroll
        for (int i = 0; i < 16; ++i) { const int l = i ^ j; if (l > i) { const unsigned x = a[i], y = a[l]; a[i] = x > y ? x : y; a[l] = x > y ? y : x; } }
}
__device__ __forceinline__ unsigned f2key(float f) { const unsigned u = __float_as_uint(f); return (u & 0x80000000u) ? ~u : (u | 0x80000000u); }
__device__ __forceinline__ float key2f(unsigned k) { return __uint_as_float((k & 0x80000000u) ? (k ^ 0x80000000u) : ~k); }

__device__ __forceinline__ void peer_half_top16(const bf16_t* QP, const bf16_t* KEYS, int tok0, int h, int half, int fr, int fq, unsigned (&top)[16]) {
    bf16x8 qf[4];
#pragma unroll
    for (int ks = 0; ks < 4; ++ks) qf[ks] = *(const bf16x8*)(QP + (size_t)(tok0 + fr) * 2048 + h * 256 + half * 128 + ks * 32 + fq * 8);
    unsigned v[32];
#pragma unroll
    for (int kt = 0; kt < 8; ++kt) { f32x4 a = (f32x4){0.f, 0.f, 0.f, 0.f};
#pragma unroll
        for (int ks = 0; ks < 4; ++ks) { const bf16x8 kf = *(const bf16x8*)(KEYS + ((size_t)((h * 2 + half) * 128 + kt * 16 + fr)) * 128 + ks * 32 + fq * 8);
            a = __builtin_amdgcn_mfma_f32_16x16x32_bf16(kf, qf[ks], a, 0, 0, 0); }
#pragma unroll
        for (int j = 0; j < 4; ++j) v[kt * 4 + j] = (f2key(a[j]) & ~127u) | (unsigned)(kt * 16 + 4 * fq + j); }
    unsigned lo[16], hi[16];
#pragma unroll
    for (int i = 0; i < 16; ++i) { lo[i] = v[i]; hi[i] = v[16 + i]; }
    bitonic_sort_desc<16>(lo); bitonic_sort_desc<16>(hi); merge_top16(lo, hi);
    unsigned pb[16];
#pragma unroll
    for (int i = 0; i < 16; ++i) pb[i] = __shfl_xor(lo[i], 16);
    merge_top16(lo, pb);
#pragma unroll
    for (int i = 0; i < 16; ++i) pb[i] = __shfl_xor(lo[i], 32);
    merge_top16(lo, pb);
#pragma unroll
    for (int i = 0; i < 16; ++i) top[i] = lo[i];
}

__device__ __forceinline__ float dot2bf(unsigned a, unsigned b, float c) { return __builtin_amdgcn_fdot2_f32_bf16(__builtin_bit_cast(bf2_t, a), __builtin_bit_cast(bf2_t, b), c, false); }
__device__ __forceinline__ void peer_route_A(const Ctx& F, int item, int slot) {
    const Params& p = F.p; const int tid = F.tid, lane = F.lane, w = F.wave, fr = lane & 15, fq = lane >> 4;
    const int tok0 = item * 16;
    const bf16_t* QP = wsb(p, OFF_XR); const bf16_t* KEYS = wsb(p, OFF_KEYS); const bf16_t* H2 = wsb(p, OFF_HBUF);
    LAS unsigned* lA = (LAS unsigned*)F.lds;
    LAS unsigned* lB = lA + 8 * 16 * 16;
    LAS unsigned* lF = lB + 8 * 16 * 16;
    LAS int* eidx = (LAS int*)(lF + 8 * 16 * 16) + slot * 2048;
    LAS float* egate = (LAS float*)((LAS int*)(lF + 8 * 16 * 16) + 4 * 2048) + slot * 2048;
    LAS float* lG = (LAS float*)((LAS int*)(lF + 8 * 16 * 16) + 8 * 2048);
    __syncthreads();
    { const int h = w; unsigned A[16], Bk[16];
      peer_half_top16(QP, KEYS, tok0, h, 0, fr, fq, A);
      peer_half_top16(QP, KEYS, tok0, h, 1, fr, fq, Bk);
      float fa[16], fb[16];
#pragma unroll
      for (int i = 0; i < 16; ++i) { fa[i] = key2f(A[i] & ~127u); fb[i] = key2f(Bk[i] & ~127u); }
      unsigned g0[16];
      { const float av = fq == 0 ? fa[0] : fq == 1 ? fa[1] : fq == 2 ? fa[2] : fa[14], bv = fq == 0 ? fb[0] : fq == 1 ? fb[0] : fq == 2 ? fb[0] : fb[0]; const unsigned ix = fq == 0 ? 0u : fq == 1 ? 16u : fq == 2 ? 32u : 224u;
        g0[0] = (f2key(av + bv) & ~255u) | ix; }
      { const float av = fq == 0 ? fa[0] : fq == 1 ? fa[1] : fq == 2 ? fa[2] : fa[15], bv = fq == 0 ? fb[1] : fq == 1 ? fb[1] : fq == 2 ? fb[1] : fb[0]; const unsigned ix = fq == 0 ? 1u : fq == 1 ? 17u : fq == 2 ? 33u : 240u;
        g0[1] = (f2key(av + bv) & ~255u) | ix; }
      { const float av = fq == 0 ? fa[0] : fq == 1 ? fa[1] : fq == 2 ? fa[2] : 0.f, bv = fq == 0 ? fb[2] : fq == 1 ? fb[2] : fq == 2 ? fb[2] : 0.f; const unsigned ix = fq == 0 ? 2u : fq == 1 ? 18u : fq == 2 ? 34u : 0u;
        g0[2] = fq == 3 ? 0u : ((f2key(av + bv) & ~255u) | ix); }
      { const float av = fq == 0 ? fa[0] : fq == 1 ? fa[1] : fq == 2 ? fa[2] : 0.f, bv = fq == 0 ? fb[3] : fq == 1 ? fb[3] : fq == 2 ? fb[3] : 0.f; const unsigned ix = fq == 0 ? 3u : fq == 1 ? 19u : fq == 2 ? 35u : 0u;
        g0[3] = fq == 3 ? 0u : ((f2key(av + bv) & ~255u) | ix); }
      { const float av = fq == 0 ? fa[0] : fq == 1 ? fa[1] : fq == 2 ? fa[2] : 0.f, bv = fq == 0 ? fb[4] : fq == 1 ? fb[4] : fq == 2 ? fb[4] : 0.f; const unsigned ix = fq == 0 ? 4u : fq == 1 ? 20u : fq == 2 ? 36u : 0u;
        g0[4] = fq == 3 ? 0u : ((f2key(av + bv) & ~255u) | ix); }
      { const float av = fq == 0 ? fa[0] : fq == 1 ? fa[1] : fq == 2 ? fa[4] : 0.f, bv = fq == 0 ? fb[5] : fq == 1 ? fb[5] : fq == 2 ? fb[0] : 0.f; const unsigned ix = fq == 0 ? 5u : fq == 1 ? 21u : fq == 2 ? 64u : 0u;
        g0[5] = fq == 3 ? 0u : ((f2key(av + bv) & ~255u) | ix); }
      { const float av = fq == 0 ? fa[0] : fq == 1 ? fa[1] : fq == 2 ? fa[4] : 0.f, bv = fq == 0 ? fb[6] : fq == 1 ? fb[6] : fq == 2 ? fb[1] : 0.f; const unsigned ix = fq == 0 ? 6u : fq == 1 ? 22u : fq == 2 ? 65u : 0u;
        g0[6] = fq == 3 ? 0u : ((f2key(av + bv) & ~255u) | ix); }
      { const float av = fq == 0 ? fa[0] : fq == 1 ? fa[1] : fq == 2 ? fa[4] : 0.f, bv = fq == 0 ? fb[7] : fq == 1 ? fb[7] : fq == 2 ? fb[2] : 0.f; const unsigned ix = fq == 0 ? 7u : fq == 1 ? 23u : fq == 2 ? 66u : 0u;
        g0[7] = fq == 3 ? 0u : ((f2key(av + bv) & ~255u) | ix); }
      { const float av = fq == 0 ? fa[0] : fq == 1 ? fa[3] : fq == 2 ? fa[7] : 0.f, bv = fq == 0 ? fb[8] : fq == 1 ? fb[0] : fq == 2 ? fb[0] : 0.f; const unsigned ix = fq == 0 ? 8u : fq == 1 ? 48u : fq == 2 ? 112u : 0u;
        g0[8] = fq == 3 ? 0u : ((f2key(av + bv) & ~255u) | ix); }
      { const float av = fq == 0 ? fa[0] : fq == 1 ? fa[3] : fq == 2 ? fa[7] : 0.f, bv = fq == 0 ? fb[9] : fq == 1 ? fb[1] : fq == 2 ? fb[1] : 0.f; const unsigned ix = fq == 0 ? 9u : fq == 1 ? 49u : fq == 2 ? 113u : 0u;
        g0[9] = fq == 3 ? 0u : ((f2key(av + bv) & ~255u) | ix); }
      { const float av = fq == 0 ? fa[0] : fq == 1 ? fa[3] : fq == 2 ? fa[8] : 0.f, bv = fq == 0 ? fb[10] : fq == 1 ? fb[2] : fq == 2 ? fb[0] : 0.f; const unsigned ix = fq == 0 ? 10u : fq == 1 ? 50u : fq == 2 ? 128u : 0u;
        g0[10] = fq == 3 ? 0u : ((f2key(av + bv) & ~255u) | ix); }
      { const float av = fq == 0 ? fa[0] : fq == 1 ? fa[3] : fq == 2 ? fa[9] : 0.f, bv = fq == 0 ? fb[11] : fq == 1 ? fb[3] : fq == 2 ? fb[0] : 0.f; const unsigned ix = fq == 0 ? 11u : fq == 1 ? 51u : fq == 2 ? 144u : 0u;
        g0[11] = fq == 3 ? 0u : ((f2key(av + bv) & ~255u) | ix); }
      { const float av = fq == 0 ? fa[0] : fq == 1 ? fa[5] : fq == 2 ? fa[10] : 0.f, bv = fq == 0 ? fb[12] : fq == 1 ? fb[0] : fq == 2 ? fb[0] : 0.f; const unsigned ix = fq == 0 ? 12u : fq == 1 ? 80u : fq == 2 ? 160u : 0u;
        g0[12] = fq == 3 ? 0u : ((f2key(av + bv) & ~255u) | ix); }
      { const float av = fq == 0 ? fa[0] : fq == 1 ? fa[5] : fq == 2 ? fa[11] : 0.f, bv = fq == 0 ? fb[13] : fq == 1 ? fb[1] : fq == 2 ? fb[0] : 0.f; const unsigned ix = fq == 0 ? 13u : fq == 1 ? 81u : fq == 2 ? 176u : 0u;
        g0[13] = fq == 3 ? 0u : ((f2key(av + bv) & ~255u) | ix); }
      { const float av = fq == 0 ? fa[0] : fq == 1 ? fa[6] : fq == 2 ? fa[12] : 0.f, bv = fq == 0 ? fb[14] : fq == 1 ? fb[0] : fq == 2 ? fb[0] : 0.f; const unsigned ix = fq == 0 ? 14u : fq == 1 ? 96u : fq == 2 ? 192u : 0u;
        g0[14] = fq == 3 ? 0u : ((f2key(av + bv) & ~255u) | ix); }
      { const float av = fq == 0 ? fa[0] : fq == 1 ? fa[6] : fq == 2 ? fa[13] : 0.f, bv = fq == 0 ? fb[15] : fq == 1 ? fb[1] : fq == 2 ? fb[0] : 0.f; const unsigned ix = fq == 0 ? 15u : fq == 1 ? 97u : fq == 2 ? 208u : 0u;
        g0[15] = fq == 3 ? 0u : ((f2key(av + bv) & ~255u) | ix); }
      bitonic_sort_desc<16>(g0);
      { unsigned pb[16];
#pragma unroll
        for (int i = 0; i < 16; ++i) pb[i] = __shfl_xor(g0[i], 16);
        merge_top16(g0, pb);
#pragma unroll
        for (int i = 0; i < 16; ++i) pb[i] = __shfl_xor(g0[i], 32);
        merge_top16(g0, pb); }
      float pe[16]; float psum = 0.f; const float pm = key2f(g0[0] & ~255u);
#pragma unroll
      for (int i = 0; i < 16; ++i) { pe[i] = __expf(key2f(g0[i] & ~255u) - pm); psum += pe[i]; }
      const float pinv = 1.f / psum;
      if (fq == 0) { LAS unsigned* a = lA + (h * 16 + fr) * 16; LAS unsigned* b2 = lB + (h * 16 + fr) * 16; LAS unsigned* f = lF + (h * 16 + fr) * 16; LAS float* g = lG + (h * 16 + fr) * 16;
#pragma unroll
          for (int i = 0; i < 16; ++i) { a[i] = A[i]; b2[i] = Bk[i]; f[i] = g0[i]; g[i] = pe[i] * pinv; } } }
    __syncthreads();
#pragma unroll
    for (int r = 0; r < 4; ++r) { const int e = tid + 512 * r, sl = e & 15, h = (e >> 4) & 7, t = e >> 7;
        const LAS unsigned* f = lF + (h * 16 + t) * 16; const unsigned key = f[sl]; const int i = (key >> 4) & 15, j = key & 15;
        const int ia = lA[(h * 16 + t) * 16 + i] & 127, ib = lB[(h * 16 + t) * 16 + j] & 127;
        eidx[t * 128 + h * 16 + sl] = ia * 128 + ib; egate[t * 128 + h * 16 + sl] = lG[(h * 16 + t) * 16 + sl]; }
    __syncthreads();
    const unsigned char* U4 = p.ws + OFF_Q; const float* RS = (const float*)(p.ws + OFF_Q + (size_t)16 * 1024 * 1024);
    for (int tt = 0; tt < 2; ++tt) { const int tl = 2 * w + tt, tok = tok0 + tl;
        f32x2 hp[8];
        {
#pragma unroll
          for (int q = 0; q < 4; ++q) { const u32x2 hq = *(const u32x2*)(H2 + (size_t)tok * 1024 + 256 * q + 4 * lane);
              hp[2 * q] = (f32x2){bflo(hq.x), bfhi(hq.x)}; hp[2 * q + 1] = (f32x2){bflo(hq.y), bfhi(hq.y)}; } }
        const int myk = ((lane >> 5) & 1) * 8 + ((lane >> 4) & 1) * 4 + ((lane >> 3) & 1) * 2 + ((lane >> 2) & 1);
        const unsigned char* ubase = U4 + 8 * lane;
        const LAS int* el = eidx + tl * 128;
        u32x2 ub[2][16];
#pragma unroll
        for (int k = 0; k < 16; ++k) ub[0][k] = *(const u32x2*)(ubase + (size_t)__builtin_amdgcn_readfirstlane(el[k]) * 512);
#pragma unroll
        for (int hb = 0; hb < 8; ++hb) {
            if (hb < 7) {
#pragma unroll
                for (int k = 0; k < 16; ++k) ub[(hb + 1) & 1][k] = *(const u32x2*)(ubase + (size_t)__builtin_amdgcn_readfirstlane(el[(hb + 1) * 16 + k]) * 512); }
            const int emy = el[hb * 16 + myk]; const float rsu = RS[emy], rsv = RS[16384 + emy];
            __builtin_amdgcn_sched_barrier(0);
            float part[16];
#pragma unroll
            for (int k = 0; k < 16; ++k) { const u32x2 uw = ub[hb & 1][k];
                f32x2 a = __builtin_amdgcn_cvt_scalef32_pk_f32_fp4(uw.x, 1.0f, 0) * hp[0];
                a = __builtin_amdgcn_cvt_scalef32_pk_f32_fp4(uw.x, 1.0f, 1) * hp[1] + a;
                a = __builtin_amdgcn_cvt_scalef32_pk_f32_fp4(uw.x, 1.0f, 2) * hp[2] + a;
                a = __builtin_amdgcn_cvt_scalef32_pk_f32_fp4(uw.x, 1.0f, 3) * hp[3] + a;
                a = __builtin_amdgcn_cvt_scalef32_pk_f32_fp4(uw.y, 1.0f, 0) * hp[4] + a;
                a = __builtin_amdgcn_cvt_scalef32_pk_f32_fp4(uw.y, 1.0f, 1) * hp[5] + a;
                a = __builtin_amdgcn_cvt_scalef32_pk_f32_fp4(uw.y, 1.0f, 2) * hp[6] + a;
                a = __builtin_amdgcn_cvt_scalef32_pk_f32_fp4(uw.y, 1.0f, 3) * hp[7] + a;
                part[k] = a.x + a.y; }
            float r8[8], r4[4], r2[2], r1;
            { const bool hi = (lane & 32) != 0;
#pragma unroll
              for (int k = 0; k < 8; ++k) { const float keep = hi ? part[k + 8] : part[k], give = hi ? part[k] : part[k + 8]; r8[k] = keep + __shfl_xor(give, 32); } }
            { const bool hi = (lane & 16) != 0;
#pragma unroll
              for (int k = 0; k < 4; ++k) { const float keep = hi ? r8[k + 4] : r8[k], give = hi ? r8[k] : r8[k + 4]; r4[k] = keep + __shfl_xor(give, 16); } }
            { const bool hi = (lane & 8) != 0;
#pragma unroll
              for (int k = 0; k < 2; ++k) { const float keep = hi ? r4[k + 2] : r4[k], give = hi ? r4[k] : r4[k + 2]; r2[k] = keep + __shfl_xor(give, 8); } }
            { const bool hi = (lane & 4) != 0; const float keep = hi ? r2[1] : r2[0], give = hi ? r2[0] : r2[1]; r1 = keep + __shfl_xor(give, 4); }
            r1 += __shfl_xor(r1, 2); r1 += __shfl_xor(r1, 1);
            const float cfl = gelu_tanh(r1 * rsu) * egate[tl * 128 + hb * 16 + myk] * rsv;
            if ((lane & 3) == 0) egate[tl * 128 + hb * 16 + myk] = cfl;
        }
    }
}
__device__ __forceinline__ void peer_B(const Ctx& F, int item, int slot, bool dummy) {
    const Params& p = F.p; const int lane = F.lane, w = F.wave;
    const int tok0 = item * 16;
    const LAS int* eidx = (const LAS int*)((LAS unsigned*)F.lds + 3 * 8 * 16 * 16) + slot * 2048;
    const LAS float* coef = (const LAS float*)((const LAS int*)((LAS unsigned*)F.lds + 3 * 8 * 16 * 16) + 4 * 2048) + slot * 2048;
    const float* mod = wsf(p, OFF_MOD);
    const unsigned char* V4 = p.ws + OFF_Q + (size_t)16384 * 512;
    for (int tt = 0; tt < 2; ++tt) { const int tl = 2 * w + tt, tok = tok0 + tl, b = tok >> 12;
        f32x2 y[8];
#pragma unroll
        for (int i = 0; i < 8; ++i) y[i] = (f32x2){0.f, 0.f};
        const unsigned char* vbase = V4 + 8 * lane;
        const LAS int* el = eidx + tl * 128; const LAS float* cl = coef + tl * 128;
        u32x2 ub[2][16];
#pragma unroll
        for (int k = 0; k < 16; ++k) ub[0][k] = *(const u32x2*)(vbase + (size_t)__builtin_amdgcn_readfirstlane(el[k]) * 512);
#pragma unroll
        for (int hb = 0; hb < 8; ++hb) {
            if (hb < 7) {
#pragma unroll
                for (int k = 0; k < 16; ++k) ub[(hb + 1) & 1][k] = *(const u32x2*)(vbase + (size_t)__builtin_amdgcn_readfirstlane(el[(hb + 1) * 16 + k]) * 512); }
            __builtin_amdgcn_sched_barrier(0);
            const float cfl = cl[hb * 16 + (lane & 15)];
#pragma unroll
            for (int k = 0; k < 16; ++k) {
                const float cf = __uint_as_float(__builtin_amdgcn_readlane(__float_as_uint(cfl), k)); const f32x2 cf2 = (f32x2){cf, cf};
                const u32x2 vw = ub[hb & 1][k];
                y[0] = __builtin_amdgcn_cvt_scalef32_pk_f32_fp4(vw.x, 1.0f, 0) * cf2 + y[0]; y[1] = __builtin_amdgcn_cvt_scalef32_pk_f32_fp4(vw.x, 1.0f, 1) * cf2 + y[1];
                y[2] = __builtin_amdgcn_cvt_scalef32_pk_f32_fp4(vw.x, 1.0f, 2) * cf2 + y[2]; y[3] = __builtin_amdgcn_cvt_scalef32_pk_f32_fp4(vw.x, 1.0f, 3) * cf2 + y[3];
                y[4] = __builtin_amdgcn_cvt_scalef32_pk_f32_fp4(vw.y, 1.0f, 0) * cf2 + y[4]; y[5] = __builtin_amdgcn_cvt_scalef32_pk_f32_fp4(vw.y, 1.0f, 1) * cf2 + y[5];
                y[6] = __builtin_amdgcn_cvt_scalef32_pk_f32_fp4(vw.y, 1.0f, 2) * cf2 + y[6]; y[7] = __builtin_amdgcn_cvt_scalef32_pk_f32_fp4(vw.y, 1.0f, 3) * cf2 + y[7]; }
        }
        float* orow = p.out + (size_t)tok * 1024 + 4 * lane; const float* g2 = mod + b * 6144 + 5120 + 4 * lane;
#pragma unroll
        for (int q = 0; q < 4; ++q) { const f32x4 xv = __builtin_nontemporal_load((const f32x4*)(orow + 256 * q)), gv = *(const f32x4*)(g2 + 256 * q);
            f32x4 o; o[0] = xv[0] + gv[0] * y[2 * q].x; o[1] = xv[1] + gv[1] * y[2 * q].y; o[2] = xv[2] + gv[2] * y[2 * q + 1].x; o[3] = xv[3] + gv[3] * y[2 * q + 1].y;
            if (!dummy || o[0] == 12345.678f) __builtin_nontemporal_store(o, (f32x4*)(orow + 256 * q)); }
    }
}
__device__ __forceinline__ void peer_phase(const Ctx& F, bool dummy) {
    for (int base = F.c; base < 1024; base += 4 * F.G) {
#pragma unroll 1
        for (int j = 0; j < 4; ++j) { const int item = base + j * F.G; if (item < 1024) peer_route_A(F, item, j); }
        __syncthreads();
#pragma unroll 1
        for (int j = 0; j < 4; ++j) { const int item = base + j * F.G; if (item < 1024) peer_B(F, item, j, dummy); }
    }
}

#ifndef PEER_MODE
#define PEER_MODE 0
#endif
__device__ __forceinline__ void peer_route_simple(const Ctx& F) {
    const Params& p = F.p; const int tid = F.tid;
    const bf16_t* QP = wsb(p, OFF_XR); const bf16_t* KEYS = wsb(p, OFF_KEYS);
    int* eidxG = (int*)(p.ws + OFF_WINT); float* egateG = (float*)(p.ws + OFF_WINT + (size_t)8 * 1024 * 1024);
    LAS float* sc = (LAS float*)F.lds;
    for (int base = F.c * 128; base < 16384 * 8; base += F.G * 128) {
        if (tid < 128) { const int th = base + tid, tok = th >> 3, h = th & 7; LAS float* my = sc + tid * 257;
            for (int half = 0; half < 2; ++half) for (int k = 0; k < 128; ++k) { float d = 0.f;
                for (int dd = 0; dd < 128; ++dd) d += bf2f(QP[(size_t)tok * 2048 + h * 256 + half * 128 + dd]) * bf2f(KEYS[((size_t)(h * 2 + half) * 128 + k) * 128 + dd]);
                my[half * 128 + k] = d; }
            float ts[2][16]; int ti[2][16];
            for (int half = 0; half < 2; ++half) for (int r = 0; r < 16; ++r) { float best = -3e38f; int bi = 0; for (int k = 0; k < 128; ++k) { const float v = my[half * 128 + k]; if (v > best) { best = v; bi = k; } }
                my[half * 128 + bi] = -3e38f;
#pragma unroll
                for (int q = 0; q < 16; ++q) if (q == r) { ts[half][q] = best; ti[half][q] = bi; } }
#pragma unroll
            for (int i = 0; i < 16; ++i)
#pragma unroll
                for (int j = 0; j < 16; ++j) my[i * 16 + j] = ts[0][i] + ts[1][j];
            float bs[16]; int be[16];
            for (int r = 0; r < 16; ++r) { float best = -3e38f; int bi = 0; for (int k = 0; k < 256; ++k) { const float v = my[k]; if (v > best) { best = v; bi = k; } }
                my[bi] = -3e38f; int ia = 0, ib = 0;
#pragma unroll
                for (int q = 0; q < 16; ++q) { if (q == (bi >> 4)) ia = ti[0][q]; if (q == (bi & 15)) ib = ti[1][q]; }
#pragma unroll
                for (int q = 0; q < 16; ++q) if (q == r) { bs[q] = best; be[q] = ia * 128 + ib; } }
            float sum = 0.f;
#pragma unroll
            for (int q = 0; q < 16; ++q) sum += __expf(bs[q] - bs[0]);
#pragma unroll
            for (int q = 0; q < 16; ++q) { eidxG[(size_t)tok * 128 + h * 16 + q] = be[q]; egateG[(size_t)tok * 128 + h * 16 + q] = __expf(bs[q] - bs[0]) / sum; } }
    }
}
__device__ __forceinline__ void peer_gather_simple(const Ctx& F) {
    const Params& p = F.p; const int lane = F.lane;
    const bf16_t* H2 = wsb(p, OFF_HBUF); const bf16_t* UB = wsb(p, OFF_Q); const bf16_t* VB = UB + (size_t)16384 * 1024;
    const int* eidxG = (const int*)(p.ws + OFF_WINT); const float* egateG = (const float*)(p.ws + OFF_WINT + (size_t)8 * 1024 * 1024);
    const float* mod = wsf(p, OFF_MOD);
    for (int tok = F.c * 8 + F.wave; tok < 16384; tok += F.G * 8) { const int b = tok >> 12;
        float hv[16], y[16];
#pragma unroll
        for (int i = 0; i < 16; ++i) { hv[i] = bf2f(H2[(size_t)tok * 1024 + lane * 16 + i]); y[i] = 0.f; }
        for (int k = 0; k < 128; ++k) { const int e = eidxG[(size_t)tok * 128 + k]; const float g = egateG[(size_t)tok * 128 + k];
            float d = 0.f;
#pragma unroll
            for (int i = 0; i < 16; ++i) d += hv[i] * bf2f(UB[(size_t)e * 1024 + lane * 16 + i]);
#pragma unroll
            for (int o = 1; o < 64; o <<= 1) d += __shfl_xor(d, o);
            const float cf = gelu_tanh(d) * g;
#pragma unroll
            for (int i = 0; i < 16; ++i) y[i] += cf * bf2f(VB[(size_t)e * 1024 + lane * 16 + i]); }
#pragma unroll
        for (int i = 0; i < 16; ++i) { const int col = lane * 16 + i; p.out[(size_t)tok * 1024 + col] += mod[b * 6144 + 5120 + col] * y[i]; }
    }
}


#define XB_TMO      128
#define XB_XCNT(j)  (256  + 64 * (j))
#define XB_XSUB(j)  (1280 + 64 * (j))
#define XB_XGEN(j)  (2304 + 64 * (j))
#define XB_TOP      3328
#define XB_TOPGEN   3392
#define XCD_BAR_WORDS 3456
#define XB_SPIN_CAP (1u << 22)
__device__ __forceinline__ unsigned xb_ld(unsigned* p)              { return __hip_atomic_load(p, __ATOMIC_RELAXED, __HIP_MEMORY_SCOPE_AGENT); }
__device__ __forceinline__ unsigned xb_add(unsigned* p, unsigned v) { return __hip_atomic_fetch_add(p, v, __ATOMIC_RELAXED, __HIP_MEMORY_SCOPE_AGENT); }
__device__ __forceinline__ unsigned xb_xcc_id() { return (unsigned)__builtin_amdgcn_s_getreg((3 << 11) | 20) & 0xFu; }
#define XB_SPIN(cond, bar) do { unsigned _sp = 0; while (cond) { __builtin_amdgcn_s_sleep(1); \
    if ((++_sp & 255u) == 0u) { if (xb_ld(&(bar)[XB_TMO])) break; if (_sp > XB_SPIN_CAP) { atomicAdd(&(bar)[XB_TMO], 1u); break; } } } } while (0)
struct XcdBarrier { unsigned* bar; unsigned x; volatile LAS unsigned* st; };
__device__ __forceinline__ XcdBarrier xcd_barrier_post(unsigned* bar, volatile LAS unsigned* st) {
    XcdBarrier b; b.bar = bar; b.x = xb_xcc_id(); b.st = st;
    if (threadIdx.x == 0) (void)xb_add(&bar[XB_XCNT(b.x)], 1u);
    return b;
}
__device__ __forceinline__ void xcd_barrier_complete(unsigned* bar, unsigned x, unsigned& nloc, unsigned& nx) {
    const unsigned G = gridDim.x * gridDim.y * gridDim.z;
    unsigned sum, cnt, mine, sp = 0u;
    for (;;) {
        sum = 0u; cnt = 0u; mine = 0u;
#pragma unroll
        for (unsigned j = 0; j < 16; ++j) { const unsigned c = xb_ld(&bar[XB_XCNT(j)]); sum += c; cnt += (c > 0u) ? 1u : 0u; mine = (j == x) ? c : mine; }
        if (sum == G) break;
        __builtin_amdgcn_s_sleep(1);
        if ((++sp & 255u) == 0u) { if (xb_ld(&bar[XB_TMO])) break; if (sp > XB_SPIN_CAP) { atomicAdd(&bar[XB_TMO], 1u); break; } }
    }
    nloc = mine > 0u ? mine : 1u; nx = cnt > 0u ? cnt : 1u;
}
__device__ __forceinline__ void xcd_barrier(const XcdBarrier& b) {
    asm volatile("s_waitcnt vmcnt(0)" ::: "memory");
    __syncthreads();
    if (threadIdx.x == 0) {
        unsigned* bar = b.bar;
        __builtin_amdgcn_s_waitcnt(0);
        unsigned nloc = b.st[0], nx = b.st[1];
        if (nloc == 0u) { xcd_barrier_complete(bar, b.x, nloc, nx); b.st[0] = nloc; b.st[1] = nx; }
        const unsigned old = xb_add(&bar[XB_XSUB(b.x)], 1u);
        const unsigned gen = old / nloc;
        if (old + 1u == (gen + 1u) * nloc) {
            __builtin_amdgcn_fence(__ATOMIC_RELEASE, "agent");
            asm volatile("s_waitcnt vmcnt(0)" ::: "memory");
            const unsigned og = xb_add(&bar[XB_TOP], 1u);
            const unsigned tg = og / nx;
            if (og + 1u == (tg + 1u) * nx) xb_add(&bar[XB_TOPGEN], 1u);
            else XB_SPIN(xb_ld(&bar[XB_TOPGEN]) == tg, bar);
            __builtin_amdgcn_fence(__ATOMIC_ACQUIRE, "agent");
            xb_add(&bar[XB_XGEN(b.x)], 1u);
            asm volatile("s_waitcnt vmcnt(0)" ::: "memory");
        } else {
            XB_SPIN(xb_ld(&bar[XB_XGEN(b.x)]) == gen, bar);
            __builtin_amdgcn_fence(__ATOMIC_ACQUIRE, "agent");
            asm volatile("s_waitcnt vmcnt(0)" ::: "memory");
        }
    }
    __syncthreads();
}

constexpr int NPHASE = 10;
template <int PH, bool DUMMY = false> __device__ __forceinline__ void run_phase(const Ctx& F0) {
    Ctx F = F0; { int t_ = F0.tid; asm volatile("" : "+v"(t_)); F.tid = t_; F.lane = t_ & 63; }
    const Params& p = F.p;
    if (PH == 0) phase0(F);
    if (PH == 1) norm_rows(F, p.x, p.ctx, NR, p.norm1_w, 0, 1024, wsb(p, OFF_HBUF));
    if (PH == 2) { G1Order S; S.init(F.G, F.c);
        EpiG1 E{p.ws, (unsigned char*)p.out, DUMMY};
        pg8::gemm_phase<EpiG1, G1Order, GP_ALIGN, GP_SP2>(F.lds, pg8::Gemm{wsb(p, OFF_HBUF), wsb(p, OFF_WINT), NR, INC, 1024}, S, E);
        if (!DUMMY) { const int maxu = (1440 + F.G - 1) / F.G, c0 = 1440 - (maxu - 1) * F.G;
            int rank = F.c, stride = F.G; if (c0 < F.G) { if (F.c < c0) rank = -1; else { rank = F.c - c0; stride = F.G - c0; } }
            if (rank >= 0) { LAS float* tile = (LAS float*)F.lds;
                constexpr int I_WOA = 8 * 16, I_WOL = 16 * 16, I_WOUT = 16 * 16, I_WPQ = 16 * 32;
                for (int it = rank; it < I_WOA + I_WOL + I_WOUT + I_WPQ; it += stride) { int r = it;
                    if (r < I_WOA) { transpose_item(p.w_o_attn, 512, 1024, wsb(p, OFF_WOAT), r, tile, F.tid); continue; } r -= I_WOA;
                    if (r < I_WOL) { transpose_item(p.w_o_lru, 1024, 1024, wsb(p, OFF_WOLT), r, tile, F.tid); continue; } r -= I_WOL;
                    if (r < I_WOUT) { transpose_item(p.w_out, 1024, 1024, wsb(p, OFF_WOUTT), r, tile, F.tid); continue; } r -= I_WOUT;
                    transpose_item(p.peer_w_q, 1024, 2048, wsb(p, OFF_WPQT), r, tile, F.tid); } } } }
    if (PH == 3) {
        LAS float* rpbs = (LAS float*)(F.lds + 102400);
        LAS float* Mh = rpbs + 8 * 15 * 32;
        { float mw = fabsf(p.q_norm_w[F.lane] * p.k_norm_w[F.lane]), mb = 0.f;
#pragma unroll
          for (int i = 0; i < 8; ++i) { const int e = F.lane + 64 * i; if (e < 465) mb = fmaxf(mb, fabsf(p.na_rpb[F.wave * 465 + e])); }
#pragma unroll
          for (int o = 1; o < 64; o <<= 1) { mw = fmaxf(mw, __shfl_xor(mw, o)); mb = fmaxf(mb, __shfl_xor(mb, o)); }
          if (F.lane == 0) Mh[F.wave] = (8.f * mw + mb) * 1.4426950408889634f; }
        __syncthreads();
        for (int i = F.tid; i < 8 * 15 * 32; i += 512) { const int c31 = i & 31, hr = i >> 5; rpbs[i] = c31 < 31 ? p.na_rpb[hr * 31 + c31] * 1.4426950408889634f - Mh[hr / 15] : -3.0e38f; }
        __syncthreads();
#if PROBE_MASK & 1024
        if (DUMMY) return;
#endif
#if PROBE_MASK & 2048
        if (DUMMY) return;
#endif
        { LruConst C; C.n = -1; unsigned xraw[11]; int it = F.c;
          if (it < 2176) { lru_load_const(F, it & 7, C); lru_load_x(F, (it >> 3) / 68, (it >> 3) % 68, it & 7, xraw); lru_conv_to_lds(F, C, xraw, 0); }
          __syncthreads();
          for (int k = 0; it < 2176; it += F.G, k ^= 1) {
              const int nx = it + F.G;
              if (nx < 2176) lru_load_x(F, (nx >> 3) / 68, (nx >> 3) % 68, nx & 7, xraw);
              lru_summary_item(F, C, it, k);
              if (nx < 2176) { if ((nx & 7) != C.n) lru_load_const(F, nx & 7, C); lru_conv_to_lds(F, C, xraw, k ^ 1); }
              __syncthreads(); } }
        { AttnPre P; int a = F.c;
          if (a < 1024) attn_prefetch(F, a >> 8, (a >> 2) & 63, a & 3, P);
          for (; a < 1024; a += F.G) { const int na = a + F.G; attn_item(F, rpbs, a >> 8, (a >> 2) & 63, a & 3, P, na < 1024, na >> 8, (na >> 2) & 63, na & 3); } } }
    if (PH == 4) {
        { pg8::StaticOrder S; S.init(NT, 1024, F.G, F.c); EpiBf<0> E{wsb(p, OFF_Q), (const bf16_t*)p.out, nullptr, 1024};
          pg8::gemm_phase<EpiBf<0>, pg8::StaticOrder, GP_ALIGN, GP_SP2>(F.lds, pg8::Gemm{wsb(p, OFF_OA), wsb(p, OFF_WOAT), NT, 1024, 512}, S, E); }
        __syncthreads();
        for (int run = F.c; run < 256; run += F.G) lru_final_run(F, run); }
    if (PH == 5) {
        { pg8::StaticOrder S; S.init(NT, 1024, F.G, F.c); EpiBf<1> E{wsb(p, OFF_XR), (const bf16_t*)p.out + (size_t)NT * 1024, wsb(p, OFF_Q), 1024};
          pg8::gemm_phase<EpiBf<1>, pg8::StaticOrder, GP_ALIGN, GP_SP2>(F.lds, pg8::Gemm{wsb(p, OFF_HBUF), wsb(p, OFF_WOLT), NT, 1024, 1024}, S, E); } }
    if (PH == 6) { pg8::StaticOrder S; S.init(NT, 1024, F.G, F.c); EpiX1 E{p.out, p.x, wsf(p, OFF_MOD)};
        pg8::gemm_phase<EpiX1, pg8::StaticOrder, GP_ALIGN, GP_SP2>(F.lds, pg8::Gemm{wsb(p, OFF_XR), wsb(p, OFF_WOUTT), NT, 1024, 1024}, S, E); }
    if (PH == 7) {
        norm_rows(F, p.out, p.out, NT, p.norm2_w, 3072, 4096, wsb(p, OFF_HBUF));
        { unsigned char* q4 = p.ws + OFF_Q; float* RS = (float*)(p.ws + OFF_Q + (size_t)16 * 1024 * 1024);
          const int gw = F.c * 8 + F.wave, NGW = F.G * 8, lane = F.lane;
          f32x4 nv[4];
          if (gw < 32768) { const float* src = (gw < 16384 ? p.peer_u + (size_t)gw * 1024 : p.peer_v + (size_t)(gw - 16384) * 1024) + 4 * lane;
#pragma unroll
              for (int q = 0; q < 4; ++q) nv[q] = __builtin_nontemporal_load((const f32x4*)(src + 256 * q)); }
          for (int row = gw; row < 32768; row += NGW) {
              f32x4 v[4]; float ss = 0.f;
#pragma unroll
              for (int q = 0; q < 4; ++q) { v[q] = nv[q]; ss += v[q][0] * v[q][0] + v[q][1] * v[q][1] + v[q][2] * v[q][2] + v[q][3] * v[q][3]; }
              const int nrow = row + NGW;
              if (nrow < 32768) { const float* src = (nrow < 16384 ? p.peer_u + (size_t)nrow * 1024 : p.peer_v + (size_t)(nrow - 16384) * 1024) + 4 * lane;
#pragma unroll
                  for (int q = 0; q < 4; ++q) nv[q] = __builtin_nontemporal_load((const f32x4*)(src + 256 * q)); }
#pragma unroll
              for (int o = 1; o < 64; o <<= 1) ss += __shfl_xor(ss, o);
              const float sc = fmaxf(sqrtf(ss * (1.f / 1024.f)) * 0.5f, 1e-30f), inv = 1.f / sc;
              u32x2 o2;
#pragma unroll
              for (int d = 0; d < 2; ++d) { unsigned wv = 0u;
                  wv = __builtin_amdgcn_cvt_scalef32_pk_fp4_f32(wv, v[2 * d][0] * inv, v[2 * d][1] * inv, 1.0f, 0); wv = __builtin_amdgcn_cvt_scalef32_pk_fp4_f32(wv, v[2 * d][2] * inv, v[2 * d][3] * inv, 1.0f, 1);
                  wv = __builtin_amdgcn_cvt_scalef32_pk_fp4_f32(wv, v[2 * d + 1][0] * inv, v[2 * d + 1][1] * inv, 1.0f, 2); wv = __builtin_amdgcn_cvt_scalef32_pk_fp4_f32(wv, v[2 * d + 1][2] * inv, v[2 * d + 1][3] * inv, 1.0f, 3); o2[d] = wv; }
              *(u32x2*)(q4 + (size_t)row * 512 + 8 * lane) = o2;
              if (lane == 0) RS[row] = sc; } } }
    if (PH == 8) { pg8::StaticOrder S; S.init(NT, 2048, F.G, F.c); EpiBf<2> E{wsb(p, OFF_XR), nullptr, nullptr, 2048};
        pg8::gemm_phase<EpiBf<2>, pg8::StaticOrder, GP_ALIGN, GP_SP2>(F.lds, pg8::Gemm{wsb(p, OFF_HBUF), wsb(p, OFF_WPQT), NT, 2048, 1024}, S, E); }
#if PEER_MODE == 0
    if (PH == 9) peer_phase(F, DUMMY);
#else
    if (PH == 9) peer_route_simple(F);
    if (PH == 10) peer_gather_simple(F);
#endif
}

__device__ __forceinline__ Ctx make_ctx(const Params& p, LAS unsigned char* lds) {
    Ctx F; F.p = p; F.lds = lds; F.tid = threadIdx.x; F.lane = threadIdx.x & 63; F.wave = __builtin_amdgcn_readfirstlane(threadIdx.x >> 6); F.G = gridDim.x; F.c = blockIdx.x; return F;
}

#if MK_MULTI
template <int PH> __global__ void __launch_bounds__(512, 2) phase_kernel(Params p) {
    extern __shared__ __attribute__((aligned(16))) unsigned char lds_raw[];
    const Ctx F = make_ctx(p, (LAS unsigned char*)lds_raw);
    run_phase<PH>(F);
}
#else
__global__ void __launch_bounds__(512, 2) fwd_megakernel(Params p) {
    extern __shared__ __attribute__((aligned(16))) unsigned char lds_raw[];
    const Ctx F = make_ctx(p, (LAS unsigned char*)lds_raw);
    cg::grid_group grid = cg::this_grid();
    volatile LAS unsigned* xbst = (volatile LAS unsigned*)(F.lds + LDS_BYTES - 16);
    if (threadIdx.x == 0) { xbst[0] = 0u; xbst[1] = 0u; }
    __syncthreads();
    if (p.out == nullptr) grid.sync();
    const XcdBarrier xb = xcd_barrier_post((unsigned*)(p.ws + OFF_BAR), xbst);
#if PROBE_MASK & 1
    run_phase<0, true>(F); xcd_barrier(xb);
#endif
    run_phase<0>(F); xcd_barrier(xb);
#if PROBE_MASK & 2
    run_phase<1, true>(F); xcd_barrier(xb);
#endif
    run_phase<1>(F); xcd_barrier(xb);
#if PROBE_MASK & 4
    run_phase<2, true>(F); xcd_barrier(xb);
#endif
    run_phase<2>(F); xcd_barrier(xb);
#if PROBE_MASK & (8 | 1024 | 2048)
    run_phase<3, true>(F); xcd_barrier(xb);
#endif
    run_phase<3>(F); xcd_barrier(xb);
#if PROBE_MASK & 16
    run_phase<4, true>(F); xcd_barrier(xb);
#endif
    run_phase<4>(F); xcd_barrier(xb);
#if PROBE_MASK & 32
    run_phase<5, true>(F); xcd_barrier(xb);
#endif
    run_phase<5>(F); xcd_barrier(xb);
#if PROBE_MASK & 64
    run_phase<6, true>(F); xcd_barrier(xb);
#endif
    run_phase<6>(F); xcd_barrier(xb);
#if PROBE_MASK & 128
    run_phase<7, true>(F); xcd_barrier(xb);
#endif
    run_phase<7>(F); xcd_barrier(xb);
#if PROBE_MASK & 256
    run_phase<8, true>(F); xcd_barrier(xb);
#endif
    run_phase<8>(F); xcd_barrier(xb);
#if PROBE_MASK & 512
    run_phase<9, true>(F); xcd_barrier(xb);
#endif
    run_phase<9>(F);
}
#endif

extern "C" void kernel_launch(void* const* d_in, const int* in_sizes, int n_in, void* d_out, int out_size, void* d_ws, size_t ws_size, hipStream_t stream) {
    static int grid = 0;
    if (grid == 0) {
        if (n_in != 26 || ws_size < WS_END) { fprintf(stderr, "kernel_launch: unexpected n_in %d / ws %zu\n", n_in, ws_size); grid = -1; return; }
        int dev = 0, cus = 0; hipGetDevice(&dev); hipDeviceGetAttribute(&cus, hipDeviceAttributeMultiprocessorCount, dev);
#if MK_MULTI
        hipFuncSetAttribute((const void*)phase_kernel<0>, hipFuncAttributeMaxDynamicSharedMemorySize, LDS_BYTES);
        hipFuncSetAttribute((const void*)phase_kernel<1>, hipFuncAttributeMaxDynamicSharedMemorySize, LDS_BYTES);
        hipFuncSetAttribute((const void*)phase_kernel<2>, hipFuncAttributeMaxDynamicSharedMemorySize, LDS_BYTES);
        hipFuncSetAttribute((const void*)phase_kernel<3>, hipFuncAttributeMaxDynamicSharedMemorySize, LDS_BYTES);
        hipFuncSetAttribute((const void*)phase_kernel<4>, hipFuncAttributeMaxDynamicSharedMemorySize, LDS_BYTES);
        hipFuncSetAttribute((const void*)phase_kernel<5>, hipFuncAttributeMaxDynamicSharedMemorySize, LDS_BYTES);
        hipFuncSetAttribute((const void*)phase_kernel<6>, hipFuncAttributeMaxDynamicSharedMemorySize, LDS_BYTES);
        hipFuncSetAttribute((const void*)phase_kernel<7>, hipFuncAttributeMaxDynamicSharedMemorySize, LDS_BYTES);
        hipFuncSetAttribute((const void*)phase_kernel<8>, hipFuncAttributeMaxDynamicSharedMemorySize, LDS_BYTES);
        hipFuncSetAttribute((const void*)phase_kernel<9>, hipFuncAttributeMaxDynamicSharedMemorySize, LDS_BYTES);
#if PEER_MODE != 0
        hipFuncSetAttribute((const void*)phase_kernel<10>, hipFuncAttributeMaxDynamicSharedMemorySize, LDS_BYTES);
#endif
        grid = cus > 0 ? cus : 256;
#else
        hipFuncSetAttribute((const void*)fwd_megakernel, hipFuncAttributeMaxDynamicSharedMemorySize, LDS_BYTES);
        int per_cu = 0; hipOccupancyMaxActiveBlocksPerMultiprocessor(&per_cu, (const void*)fwd_megakernel, 512, LDS_BYTES);
        if (per_cu < 1) { fprintf(stderr, "kernel_launch: occupancy query says %d\n", per_cu); per_cu = 1; }
        grid = (cus > 0 ? cus : 256) * 1;
#endif
        (void)hipGetLastError();
    }
    if (grid < 0) return;
    Params p{};
    const float** pp = (const float**)&p;
    for (int i = 0; i < 26; ++i) pp[i] = (const float*)d_in[i];
    p.out = (float*)d_out; p.ws = (unsigned char*)d_ws;
#if MK_MULTI
    phase_kernel<0><<<grid, 512, LDS_BYTES, stream>>>(p);
    phase_kernel<1><<<grid, 512, LDS_BYTES, stream>>>(p);
    phase_kernel<2><<<grid, 512, LDS_BYTES, stream>>>(p);
    phase_kernel<3><<<grid, 512, LDS_BYTES, stream>>>(p);
    phase_kernel<4><<<grid, 512, LDS_BYTES, stream>>>(p);
    phase_kernel<5><<<grid, 512, LDS_BYTES, stream>>>(p);
    phase_kernel<6><<<grid, 512, LDS_BYTES, stream>>>(p);
    phase_kernel<7><<<grid, 512, LDS_BYTES, stream>>>(p);
    phase_kernel<8><<<grid, 512, LDS_BYTES, stream>>>(p);
    phase_kernel<9><<<grid, 512, LDS_BYTES, stream>>>(p);
#if PEER_MODE != 0
    phase_kernel<10><<<grid, 512, LDS_BYTES, stream>>>(p);
#endif
#else
    (void)hipMemsetAsync((unsigned char*)d_ws + OFF_BAR, 0, 16384, stream);
    void* args[] = {&p};
    hipError_t e = hipLaunchCooperativeKernel((const void*)fwd_megakernel, dim3(grid), dim3(512), args, LDS_BYTES, stream);
    if (e != hipSuccess) fprintf(stderr, "cooperative launch failed: %s (grid %d)\n", hipGetErrorString(e), grid);
#endif
}
```

```cpp
#include <hip/hip_runtime.h>
#include <hip/hip_cooperative_groups.h>
#include <cstdio>
#include <cstdint>
namespace cg = cooperative_groups;

#ifndef PROBE_MASK
#define PROBE_MASK 0
#endif
#ifndef GP_SP2
#define GP_SP2 true
#endif
#ifndef GP_ALIGN
#define GP_ALIGN true
#endif
#ifndef MK_MULTI
#define MK_MULTI 0
#endif

#define LAS __attribute__((address_space(3)))
typedef __bf16 bf2_t __attribute__((ext_vector_type(2)));
typedef unsigned u32x2 __attribute__((ext_vector_type(2)));
typedef float f32x2 __attribute__((ext_vector_type(2)));

namespace pg8 {
#define PG8_LAS __attribute__((address_space(3)))
typedef unsigned short bf16_t;
typedef short bf16x8 __attribute__((ext_vector_type(8)));
typedef float f32x4 __attribute__((ext_vector_type(4)));
typedef unsigned u32x4 __attribute__((ext_vector_type(4)));
constexpr int BM = 256, BK = 64, HALF = 128, HTB = HALF * BK * 2  , STAGE_BYTES = 8 * HTB, NXCD = 8, WGM = 4;

__host__ __device__ __forceinline__ int lds_byte(int r, int c) { const int st = (r >> 4) * 2 + (c >> 5), rr = r & 15, cc = c & 31, ob = rr * 64 + cc * 2; return st * 1024 + (ob ^ (((ob >> 9) & 1) << 5)); }
__host__ __device__ __forceinline__ void stage_rc(int b, int& R, int& C) { const int st = b / 1024, sb = b % 1024, swz = sb ^ (((sb >> 9) & 1) << 5); R = (st >> 1) * 16 + swz / 64; C = (st & 1) * 32 + (swz % 64) / 2; }
__host__ __device__ __forceinline__ int perm32(int rho) { const int n = rho >> 4, i = rho & 15; return 8 * (i >> 2) + 4 * n + (i & 3); }

struct Unit { int pm, pn; };
struct Gemm { const bf16_t* A; const bf16_t* Bt; int M, N, K; };


struct StaticOrder {
    int nM, nN, nwg, G, c, wgm;
    __host__ __device__ __forceinline__ void init(int M, int N, int G_, int c_, int wgm_ = WGM) { nM = M / BM; nN = N / BM; nwg = nM * nN; G = G_; c = c_; wgm = wgm_; }
    __host__ __device__ __forceinline__ bool next(int i, Unit& u) const {
        const long L = (long)i * G + c; if (L >= nwg) return false;
        int wgid = (int)L; { const int q = nwg / NXCD, r = nwg % NXCD, xcd = wgid % NXCD, off = wgid / NXCD; wgid = (xcd < r ? xcd * (q + 1) : r * (q + 1) + (xcd - r) * q) + off; }
        const int nig = wgm * nN, gid = wgid / nig, fm = gid * wgm, gsz = (nM - fm) < wgm ? (nM - fm) : wgm;
        u.pm = fm + ((wgid % nig) % gsz); u.pn = (wgid % nig) / gsz; return true;
    }
    __device__ __forceinline__ void a_ready(const Unit&) const {}
    __device__ __forceinline__ void done(const Unit&) const {}
};
__device__ __forceinline__ unsigned cvt_pk_bf16(float lo, float hi) { unsigned r; asm volatile("v_cvt_pk_bf16_f32 %0, %1, %2" : "=v"(r) : "v"(lo), "v"(hi)); return r; }
template <class Epi, class Sched, bool ALIGN_EPI = false, bool SP2 = false>
__device__ __forceinline__ void gemm_phase(PG8_LAS unsigned char* lds, const Gemm g, const Sched& S, const Epi& E) {
    int tid_ = threadIdx.x; asm volatile("" : "+v"(tid_));
    const int tid = tid_, wid = __builtin_amdgcn_readfirstlane(tid >> 6), lane = tid & 63, wr = wid >> 2, wc = wid & 3, fr = lane & 15, fq = lane >> 4;
    const int K = g.K, nt = K / BK;
    unsigned voffA[2], voffB[2];
#pragma unroll
    for (int i = 0; i < 2; ++i) { int R, C; stage_rc(tid * 16 + i * 8192, R, C); const int Rb = Epi::PERM ? ((R & ~31) + perm32(R & 31)) : R;
        voffA[i] = (unsigned)(R * K + C) * 2u; voffB[i] = (unsigned)(Rb * K + C) * 2u; }
    const size_t kstep = (size_t)(BK * 2);
    const size_t hstep = (size_t)HALF * K * 2;
    const size_t tstep = 2 * hstep;
    const unsigned ldsw = (unsigned)wid * 1024u;
    const int aoff = lds_byte(wr * 64 + fr, fq * 8), boff = lds_byte(wc * 32 + fr, fq * 8);
#define PG8_SA(b, h) (((b) * 2 + (h)) * HTB)
#define PG8_SB(b, h) ((4 + (b) * 2 + (h)) * HTB)
#define PG8_STAGE(bufoff, gbase, voff) do { _Pragma("unroll") for (int _i = 0; _i < 2; ++_i) \
        __builtin_amdgcn_global_load_lds((const unsigned*)((const char*)(gbase) + (voff)[_i]), (PG8_LAS unsigned*)(lds + (bufoff) + ldsw + _i * 8192), 16, 0, 0); } while (0)
#define PG8_LDA(dst, b, h) do { _Pragma("unroll") for (int m = 0; m < 4; ++m) _Pragma("unroll") for (int k = 0; k < 2; ++k) dst[m][k] = *(const PG8_LAS bf16x8*)(lds + PG8_SA(b, h) + aoff + m * 2048 + k * 1024); } while (0)
#define PG8_LDB(dst, b, h) do { _Pragma("unroll") for (int n = 0; n < 2; ++n) _Pragma("unroll") for (int k = 0; k < 2; ++k) dst[n][k] = *(const PG8_LAS bf16x8*)(lds + PG8_SB(b, h) + boff + n * 2048 + k * 1024); } while (0)
#define PG8_MMA(ai, bj, At, Bt) do { __builtin_amdgcn_s_setprio(1); _Pragma("unroll") for (int m = 0; m < 4; ++m) _Pragma("unroll") for (int n = 0; n < 2; ++n) _Pragma("unroll") for (int k = 0; k < 2; ++k) \
        acc[ai][bj][m][n] = __builtin_amdgcn_mfma_f32_16x16x32_bf16(Bt[n][k], At[m][k], acc[ai][bj][m][n], 0, 0, 0); __builtin_amdgcn_s_setprio(0); } while (0)
#define PG8_WAIT_V(n) asm volatile("s_waitcnt vmcnt(" #n ")" ::: "memory")
#define PG8_WAIT_L(n) asm volatile("s_waitcnt lgkmcnt(" #n ")" ::: "memory")
#define PG8_BAR __builtin_amdgcn_s_barrier()
#define PG8_SCHED __builtin_amdgcn_sched_barrier(0)
    Unit cur, nxt; int ui = 0;
    if (!S.next(0, cur)) return;
    f32x4 acc[2][2][4][2];
#pragma unroll
    for (int a = 0; a < 2; ++a)
#pragma unroll
        for (int b = 0; b < 2; ++b)
#pragma unroll
            for (int m = 0; m < 4; ++m)
#pragma unroll
                for (int n = 0; n < 2; ++n) acc[a][b][m][n] = (f32x4){0.f, 0.f, 0.f, 0.f};
    bf16x8 At[4][2], B0[2][2], B1[2][2];
    const char* cA = (const char*)g.A + (size_t)cur.pm * tstep; const char* cB = (const char*)g.Bt + (size_t)cur.pn * tstep;
    S.a_ready(cur);
    if constexpr (SP2) {
        PG8_STAGE(PG8_SB(0, 0), cB, voffB); PG8_STAGE(PG8_SB(0, 1), cB + hstep, voffB); PG8_STAGE(PG8_SA(0, 0), cA, voffA); PG8_STAGE(PG8_SA(0, 1), cA + hstep, voffA);
        if (wr == 1) PG8_BAR;
        PG8_WAIT_V(2); PG8_BAR;
        PG8_STAGE(PG8_SB(1, 0), cB + kstep, voffB); PG8_STAGE(PG8_SA(1, 0), cA + kstep, voffA); PG8_STAGE(PG8_SB(1, 1), cB + hstep + kstep, voffB);
        PG8_WAIT_V(6); PG8_BAR;
    } else {
        PG8_STAGE(PG8_SB(0, 0), cB, voffB); PG8_STAGE(PG8_SA(0, 0), cA, voffA); PG8_STAGE(PG8_SB(0, 1), cB + hstep, voffB); PG8_STAGE(PG8_SA(0, 1), cA + hstep, voffA);
        if (wr == 1) PG8_BAR;
        PG8_WAIT_V(4); PG8_BAR;
        PG8_STAGE(PG8_SB(1, 0), cB + kstep, voffB); PG8_STAGE(PG8_SA(1, 0), cA + kstep, voffA); PG8_STAGE(PG8_SB(1, 1), cB + hstep + kstep, voffB);
        PG8_WAIT_V(6); PG8_BAR;
    }
    for (;;) {
        const bool has_next = S.next(ui + 1, nxt);
        const char* nA = has_next ? (const char*)g.A + (size_t)nxt.pm * tstep : cA; const char* nB = has_next ? (const char*)g.Bt + (size_t)nxt.pn * tstep : cB;
        for (int t = 0; t < nt; t += 2) {
            const bool last = (t == nt - 2);
            const char* a1 = cA + (size_t)(t + 1) * kstep;
            const char* a2 = last ? nA : cA + (size_t)(t + 2) * kstep; const char* b2 = last ? nB : cB + (size_t)(t + 2) * kstep;
            const char* a3 = a2 + kstep; const char* b3 = b2 + kstep;
            if (last && has_next) S.a_ready(nxt);
            if constexpr (SP2) {
            PG8_LDB(B0, 0, 0); PG8_LDB(B1, 0, 1); PG8_SCHED; PG8_LDA(At, 0, 0); PG8_STAGE(PG8_SA(1, 1), a1 + hstep, voffA);
            PG8_WAIT_V(8); PG8_WAIT_L(0); PG8_BAR; PG8_MMA(0, 0, At, B0); PG8_MMA(0, 1, At, B1); PG8_BAR; PG8_SCHED;
            PG8_LDA(At, 0, 1); PG8_STAGE(PG8_SB(0, 0), b2, voffB); PG8_STAGE(PG8_SB(0, 1), b2 + hstep, voffB); PG8_STAGE(PG8_SA(0, 0), a2, voffA);
            PG8_WAIT_V(8); PG8_WAIT_L(0); PG8_BAR; PG8_MMA(1, 0, At, B0); PG8_MMA(1, 1, At, B1); PG8_BAR; PG8_SCHED;
            PG8_LDB(B0, 1, 0); PG8_LDB(B1, 1, 1); PG8_SCHED; PG8_LDA(At, 1, 0); PG8_STAGE(PG8_SA(0, 1), a2 + hstep, voffA);
            PG8_WAIT_V(8); PG8_WAIT_L(0); PG8_BAR; PG8_MMA(0, 0, At, B0); PG8_MMA(0, 1, At, B1); PG8_BAR; PG8_SCHED;
            PG8_LDA(At, 1, 1); PG8_STAGE(PG8_SB(1, 0), b3, voffB); PG8_STAGE(PG8_SB(1, 1), b3 + hstep, voffB); PG8_STAGE(PG8_SA(1, 0), a3, voffA);
            PG8_WAIT_V(8); PG8_WAIT_L(0); PG8_BAR; PG8_MMA(1, 0, At, B0); PG8_MMA(1, 1, At, B1); PG8_BAR; PG8_SCHED;
            } else {
            PG8_LDB(B0, 0, 0); PG8_SCHED; PG8_LDA(At, 0, 0); PG8_STAGE(PG8_SA(1, 1), a1 + hstep, voffA);
            PG8_WAIT_L(8); PG8_BAR; PG8_WAIT_L(0); PG8_MMA(0, 0, At, B0); PG8_BAR; PG8_SCHED;
            PG8_LDB(B1, 0, 1); PG8_STAGE(PG8_SB(0, 0), b2, voffB);
            PG8_BAR; PG8_WAIT_L(0); PG8_MMA(0, 1, At, B1); PG8_BAR;
            PG8_LDA(At, 0, 1); PG8_STAGE(PG8_SA(0, 0), a2, voffA);
            PG8_BAR; PG8_WAIT_L(0); PG8_MMA(1, 0, At, B0); PG8_BAR; PG8_SCHED;
            PG8_STAGE(PG8_SB(0, 1), b2 + hstep, voffB);
            PG8_WAIT_V(6); PG8_BAR; PG8_MMA(1, 1, At, B1); PG8_BAR;
            PG8_LDB(B0, 1, 0); PG8_SCHED; PG8_LDA(At, 1, 0); PG8_STAGE(PG8_SA(0, 1), a2 + hstep, voffA);
            PG8_WAIT_L(8); PG8_BAR; PG8_WAIT_L(0); PG8_MMA(0, 0, At, B0); PG8_BAR; PG8_SCHED;
            PG8_LDB(B1, 1, 1); PG8_STAGE(PG8_SB(1, 0), b3, voffB);
            PG8_BAR; PG8_WAIT_L(0); PG8_MMA(0, 1, At, B1); PG8_BAR;
            PG8_LDA(At, 1, 1); PG8_STAGE(PG8_SA(1, 0), a3, voffA);
            PG8_BAR; PG8_WAIT_L(0); PG8_MMA(1, 0, At, B0); PG8_BAR; PG8_SCHED;
            PG8_STAGE(PG8_SB(1, 1), b3 + hstep, voffB);
            PG8_WAIT_V(6); PG8_BAR; PG8_MMA(1, 1, At, B1); PG8_BAR;
            }
        }
        if constexpr (ALIGN_EPI) { if (wr == 0) PG8_BAR; }
        if constexpr (!Epi::AFTER_DRAIN) { E(acc, cur, wr, wc, fr, fq); S.done(cur); }
        if (!has_next) break;
#pragma unroll
        for (int a = 0; a < 2; ++a)
#pragma unroll
            for (int b = 0; b < 2; ++b)
#pragma unroll
                for (int m = 0; m < 4; ++m)
#pragma unroll
                    for (int n = 0; n < 2; ++n) acc[a][b][m][n] = (f32x4){0.f, 0.f, 0.f, 0.f};
        cur = nxt; cA = nA; cB = nB; ++ui;
        if constexpr (ALIGN_EPI) { if (wr == 1) PG8_BAR; }
    }
    PG8_WAIT_V(0);
    if constexpr (!ALIGN_EPI) { if (wr == 0) PG8_BAR; }
    PG8_BAR;
    if constexpr (Epi::AFTER_DRAIN) { E.fused(acc, cur, wr, wc, fr, fq, lds, wid, lane); S.done(cur); }
#undef PG8_SA
#undef PG8_SB
#undef PG8_STAGE
#undef PG8_LDA
#undef PG8_LDB
#undef PG8_MMA
#undef PG8_WAIT_V
#undef PG8_WAIT_L
#undef PG8_BAR
#undef PG8_SCHED
}

}
using pg8::bf16_t; using pg8::bf16x8; using pg8::f32x4; using pg8::u32x4; using pg8::Unit; using pg8::cvt_pk_bf16;

constexpr int DM = 1024, NB = 4, SEQ = 4096, CTX = 256, NT = NB * SEQ, NC = NB * CTX, NR = NT + NC, SP = SEQ + CTX;
constexpr int INC = 5632;
constexpr float EPS = 1e-6f;
constexpr int LDS_BYTES = 147456;

constexpr size_t al256(size_t x) { return (x + 255) & ~(size_t)255; }
constexpr size_t OFF_MOD = 0;
constexpr size_t OFF_QSS = al256(OFF_MOD + 5 * 6144 * 4);
constexpr size_t OFF_KSS = al256(OFF_QSS + (size_t)NB * 8 * SP * 4);
constexpr size_t OFF_CHK = al256(OFF_KSS + (size_t)NB * 8 * SP * 4);
constexpr size_t OFF_WINT = al256(OFF_CHK + (size_t)NB * 68 * 4 * 1024 * 4);
constexpr size_t OFF_WOAT = al256(OFF_WINT + (size_t)INC * 1024 * 2);
constexpr size_t OFF_WOLT = al256(OFF_WOAT + (size_t)1024 * 512 * 2);
constexpr size_t OFF_WOUTT = al256(OFF_WOLT + (size_t)1024 * 1024 * 2);
constexpr size_t OFF_WPQT = al256(OFF_WOUTT + (size_t)1024 * 1024 * 2);
constexpr size_t OFF_KEYS = al256(OFF_WPQT + (size_t)2048 * 1024 * 2);
constexpr size_t OFF_LRUW = al256(OFF_KEYS + (size_t)8 * 2 * 128 * 128 * 2);
constexpr size_t OFF_HBUF = al256(OFF_LRUW + (size_t)32 * 128 * 128 * 2);
constexpr size_t OFF_Q = al256(OFF_HBUF + (size_t)NR * 1024 * 2);
constexpr size_t OFF_K = al256(OFF_Q + (size_t)NT * 512 * 2);
constexpr size_t OFF_VT = al256(OFF_K + (size_t)NB * SP * 512 * 2);
constexpr size_t OFF_OA = al256(OFF_VT + (size_t)NB * 8 * 64 * SP * 2);
constexpr size_t OFF_XR = al256(OFF_OA + (size_t)NT * 512 * 2);
constexpr size_t OFF_YG = al256(OFF_XR + (size_t)NR * 1024 * 2);
constexpr size_t OFF_BAR = al256(OFF_YG + (size_t)NT * 1024 * 2);
constexpr size_t OFF_LRD = al256(OFF_BAR + 16384);
constexpr size_t WS_END = al256(OFF_LRD + (size_t)2048 * 4 * 512 * 16);
static_assert(OFF_XR - OFF_Q >= (size_t)2 * 16384 * 1024 * 2, "u/v overlay");
static_assert(OFF_VT - OFF_Q >= (size_t)NT * 1024 * 2, "T1 overlay on q|k");
static_assert(OFF_BAR - OFF_XR >= (size_t)NT * 2048 * 2, "q_p overlay");
static_assert(WS_END <= (size_t)275000000, "workspace (ws_size >= sum of the inputs = 275.8 MB)");

struct Params {
    const float *x, *c, *ctx, *c_ctx, *w_ada, *b_ada, *norm1_w, *norm2_w, *w_in, *q_norm_w, *k_norm_w, *na_rpb, *conv_w, *conv_b,
        *lru_w_a, *lru_b_a, *lru_w_x, *lru_b_x, *lru_lambda, *w_o_attn, *w_o_lru, *w_out, *peer_w_q, *peer_keys, *peer_u, *peer_v;
    float* out; unsigned char* ws;
};

__device__ __forceinline__ float bf2f(unsigned short h) { return __uint_as_float(((unsigned)h) << 16); }
__device__ __forceinline__ float bflo(unsigned w) { return __uint_as_float(w << 16); }
__device__ __forceinline__ float bfhi(unsigned w) { return __uint_as_float(w & 0xffff0000u); }
__device__ __forceinline__ float sigmoidf_(float x) { return __builtin_amdgcn_rcpf(1.f + __expf(-x)); }
__device__ __forceinline__ float gelu_tanh(float x) { const float z = 0.7978845608f * (x + 0.044715f * x * x * x); return x * __builtin_amdgcn_rcpf(1.f + __expf(-2.f * z)); }
__device__ __forceinline__ float silu_(float x) { return x * sigmoidf_(x); }
__device__ __forceinline__ u32x4 pack8(const f32x4& a, const f32x4& b) { u32x4 w; w.x = cvt_pk_bf16(a[0], a[1]); w.y = cvt_pk_bf16(a[2], a[3]); w.z = cvt_pk_bf16(b[0], b[1]); w.w = cvt_pk_bf16(b[2], b[3]); return w; }

struct G1Order {
    pg8::StaticOrder so; int G, c;
    __device__ __forceinline__ void init(int G_, int c_) { so.init(NT, INC, G_, c_, 4); G = G_; c = c_; }
    __device__ __forceinline__ bool next(int i, Unit& u) const {
        long L = (long)i * G + c;
        if (L < 1408) return so.next(i, u);
        L -= 1408; if (L >= 32) return false;
        u.pm = 64 + (int)(L & 3); u.pn = 2 + (int)(L >> 2); return true;
    }
    __device__ __forceinline__ void a_ready(const Unit&) const {}
    __device__ __forceinline__ void done(const Unit&) const {}
};

struct EpiG1 {
    static constexpr bool PERM = true, AFTER_DRAIN = false;
    unsigned char* ws; unsigned char* outb; bool dummy;
    __device__ __forceinline__ void operator()(const f32x4 (&acc)[2][2][4][2], const Unit& u, int wr, int wc, int fr, int fq) const {
        const int pn = u.pn, pm = u.pm; const bool lat = pm < 64;
        bf16_t* const vT = (bf16_t*)(ws + OFF_VT);
        const int b = lat ? (pm >> 4) : (pm - 64), tok0 = lat ? ((pm & 15) << 8) : 4096;
        const int cu0 = wc * 32 + fq * 8;
        if (pn < 4) {
            const bool isq = pn < 2; bf16_t* dst = (bf16_t*)(ws + (isq ? OFF_Q : OFF_K)); float* ss = (float*)(ws + (isq ? OFF_QSS : OFF_KSS)); const int colbase = (pn & 1) * 256;
#pragma unroll
            for (int ai = 0; ai < 2; ++ai)
#pragma unroll
                for (int m = 0; m < 4; ++m) { const int tokp = tok0 + ai * 128 + wr * 64 + m * 16 + fr;
                    const size_t rowoff = isq ? (size_t)(b * SEQ + tokp) * 512 : (size_t)(b * SP + tokp) * 512;
#pragma unroll
                    for (int bj = 0; bj < 2; ++bj) { const int col = colbase + bj * 128 + cu0; const f32x4 v0 = acc[ai][bj][m][0], v1 = acc[ai][bj][m][1];
                        __builtin_nontemporal_store(pack8(v0, v1), (u32x4*)(dst + rowoff + col));
                        float s = v0[0] * v0[0] + v0[1] * v0[1] + v0[2] * v0[2] + v0[3] * v0[3] + v1[0] * v1[0] + v1[1] * v1[1] + v1[2] * v1[2] + v1[3] * v1[3];
                        s += __shfl_xor(s, 16); s += __shfl_xor(s, 32);
                        if (fq == 0 && !dummy) atomicAdd(ss + (size_t)(b * 8 + (col >> 6)) * SP + tokp, s); } }
        } else if (pn < 6) {
#pragma unroll
            for (int ai = 0; ai < 2; ++ai)
#pragma unroll
                for (int m = 0; m < 4; ++m) { const int tokp = tok0 + ai * 128 + wr * 64 + m * 16 + fr;
#pragma unroll
                    for (int bj = 0; bj < 2; ++bj) { const int col = (pn - 4) * 256 + bj * 128 + cu0; const int head = col >> 6, d0 = col & 63;
                        bf16_t* vp = vT + ((size_t)(b * 8 + head) * 64 + d0) * SP + tokp;
                        const u32x4 w = pack8(acc[ai][bj][m][0], acc[ai][bj][m][1]);
                        vp[0 * SP] = (bf16_t)(w.x & 0xffff); vp[1 * SP] = (bf16_t)(w.x >> 16); vp[2 * SP] = (bf16_t)(w.y & 0xffff); vp[3 * SP] = (bf16_t)(w.y >> 16);
                        vp[4 * SP] = (bf16_t)(w.z & 0xffff); vp[5 * SP] = (bf16_t)(w.z >> 16); vp[6 * SP] = (bf16_t)(w.w & 0xffff); vp[7 * SP] = (bf16_t)(w.w >> 16); } }
        } else {
            const int kind = (pn - 6) >> 2;
            bf16_t* dst = kind < 2 ? (bf16_t*)(ws + (kind == 0 ? OFF_XR : OFF_YG)) : (bf16_t*)(outb + (kind == 2 ? (size_t)0 : (size_t)NT * 1024 * 2)); const int colbase = ((pn - 6) & 3) * 256;
#pragma unroll
            for (int ai = 0; ai < 2; ++ai)
#pragma unroll
                for (int m = 0; m < 4; ++m) { const size_t row = (size_t)pm * 256 + ai * 128 + wr * 64 + m * 16 + fr;
#pragma unroll
                    for (int bj = 0; bj < 2; ++bj) { const int col = colbase + bj * 128 + cu0; f32x4 v0 = acc[ai][bj][m][0], v1 = acc[ai][bj][m][1];
                        if (kind == 1) {
#pragma unroll
                            for (int j = 0; j < 4; ++j) { v0[j] = gelu_tanh(v0[j]); v1[j] = gelu_tanh(v1[j]); } }
                        else if (kind >= 2) {
#pragma unroll
                            for (int j = 0; j < 4; ++j) { v0[j] = sigmoidf_(v0[j]); v1[j] = sigmoidf_(v1[j]); } }
                        __builtin_nontemporal_store(pack8(v0, v1), (u32x4*)(dst + row * 1024 + col)); } }
        }
    }
};

template <int MODE> struct EpiBf {
    static constexpr bool PERM = true, AFTER_DRAIN = false;
    bf16_t* dst; const bf16_t* gate; const bf16_t* add; int ldc;
    __device__ __forceinline__ void operator()(const f32x4 (&acc)[2][2][4][2], const Unit& u, int wr, int wc, int fr, int fq) const {
#pragma unroll
        for (int ai = 0; ai < 2; ++ai)
#pragma unroll
            for (int m = 0; m < 4; ++m) { const size_t row = (size_t)u.pm * 256 + ai * 128 + wr * 64 + m * 16 + fr;
#pragma unroll
                for (int bj = 0; bj < 2; ++bj) { const size_t off = row * ldc + u.pn * 256 + bj * 128 + wc * 32 + fq * 8; f32x4 v0 = acc[ai][bj][m][0], v1 = acc[ai][bj][m][1];
                    if (MODE <= 1) { const u32x4 g = *(const u32x4*)(gate + off);
                        v0[0] *= bflo(g.x); v0[1] *= bfhi(g.x); v0[2] *= bflo(g.y); v0[3] *= bfhi(g.y); v1[0] *= bflo(g.z); v1[1] *= bfhi(g.z); v1[2] *= bflo(g.w); v1[3] *= bfhi(g.w); }
                    if (MODE == 1) { const u32x4 t = *(const u32x4*)(add + off);
                        v0[0] += bflo(t.x); v0[1] += bfhi(t.x); v0[2] += bflo(t.y); v0[3] += bfhi(t.y); v1[0] += bflo(t.z); v1[1] += bfhi(t.z); v1[2] += bflo(t.w); v1[3] += bfhi(t.w); }
                    *(u32x4*)(dst + off) = pack8(v0, v1); } }
    }
};

struct EpiX1 {
    static constexpr bool PERM = false, AFTER_DRAIN = false;
    float* out; const float* x; const float* mod;
    __device__ __forceinline__ void operator()(const f32x4 (&acc)[2][2][4][2], const Unit& u, int wr, int wc, int fr, int fq) const {
        const int b = u.pm >> 4;
#pragma unroll
        for (int ai = 0; ai < 2; ++ai)
#pragma unroll
            for (int m = 0; m < 4; ++m) { const size_t row = (size_t)u.pm * 256 + ai * 128 + wr * 64 + m * 16 + fr;
#pragma unroll
                for (int bj = 0; bj < 2; ++bj)
#pragma unroll
                    for (int n = 0; n < 2; ++n) { const int col = u.pn * 256 + bj * 128 + wc * 32 + n * 16 + fq * 4;
                        const f32x4 g = *(const f32x4*)(mod + b * 6144 + 2048 + col), xv = *(const f32x4*)(x + row * 1024 + col);
                        *(f32x4*)(out + row * 1024 + col) = xv + g * acc[ai][bj][m][n]; } }
    }
};

struct Ctx { Params p; LAS unsigned char* lds; int tid, lane, wave, G, c; };

__device__ __forceinline__ bf16_t* wsb(const Params& p, size_t off) { return (bf16_t*)(p.ws + off); }
__device__ __forceinline__ float* wsf(const Params& p, size_t off) { return (float*)(p.ws + off); }

__device__ __forceinline__ void transpose_item(const float* W, int K, int N, bf16_t* WT, int item, LAS float* tile, int tid) {
    const int nblk = N / 64, kb = item / nblk, nb = item % nblk, k0 = kb * 64, n0 = nb * 64;
    __syncthreads();
#pragma unroll
    for (int i = 0; i < 8; ++i) { const int e = tid + 512 * i, kk = e >> 6, nn = e & 63; tile[kk * 65 + nn] = __builtin_nontemporal_load(W + (size_t)(k0 + kk) * N + n0 + nn); }
    __syncthreads();
    const int n = tid >> 3, cc = tid & 7; const LAS float* s = tile + (8 * cc) * 65 + n;
    u32x4 o; o.x = cvt_pk_bf16(s[0], s[65]); o.y = cvt_pk_bf16(s[130], s[195]); o.z = cvt_pk_bf16(s[260], s[325]); o.w = cvt_pk_bf16(s[390], s[455]);
    *(u32x4*)(WT + (size_t)(n0 + n) * K + k0 + 8 * cc) = o;
}

__device__ __forceinline__ void phase0(const Ctx& F) {
    const Params& p = F.p; const int tid = F.tid;
    LAS float* sil = (LAS float*)F.lds;
    LAS float* red = sil + 5 * 1024;
    LAS float* tile = red + 16 * 5 * 32;
    for (int i = tid; i < 5 * 1024; i += 512) { const float v = i < 4096 ? p.c[i] : p.c_ctx[i - 4096]; sil[i] = silu_(v); }
    __syncthreads();
    float* mod = wsf(p, OFF_MOD);
    constexpr int I_MOD = 192, I_WIN = 16 * 88, I_WOA = 8 * 16, I_WOL = 16 * 16, I_WOUT = 16 * 16, I_WPQ = 16 * 32, I_LRU = 32 * 4, I_KEYS = 64, I_ZERO = 68;
    constexpr int NITEMS = I_MOD + I_WIN + I_LRU + I_KEYS + I_ZERO;
    for (int it = F.c; it < NITEMS; it += F.G) {
        int r = it;
        if (r < I_MOD) {
            const int cl = tid & 31, kg = tid >> 5, col = r * 32 + cl; float a0 = 0, a1 = 0, a2 = 0, a3 = 0, a4 = 0;
#pragma unroll 32
            for (int kk = 0; kk < 64; ++kk) { const int k = kg * 64 + kk; const float w = __builtin_nontemporal_load(p.w_ada + (size_t)k * 6144 + col);
                a0 += sil[k] * w; a1 += sil[1024 + k] * w; a2 += sil[2048 + k] * w; a3 += sil[3072 + k] * w; a4 += sil[4096 + k] * w; }
            __syncthreads();
            red[(kg * 5 + 0) * 32 + cl] = a0; red[(kg * 5 + 1) * 32 + cl] = a1; red[(kg * 5 + 2) * 32 + cl] = a2; red[(kg * 5 + 3) * 32 + cl] = a3; red[(kg * 5 + 4) * 32 + cl] = a4;
            __syncthreads();
            if (tid < 160) { const int rr = tid >> 5, c2 = tid & 31; float s = 0; for (int g = 0; g < 16; ++g) s += red[(g * 5 + rr) * 32 + c2];
                mod[rr * 6144 + r * 32 + c2] = s + p.b_ada[r * 32 + c2]; }
            continue; }
        r -= I_MOD;
        if (r < I_WIN) { transpose_item(p.w_in, 1024, INC, wsb(p, OFF_WINT), r, tile, tid); continue; } r -= I_WIN;
        if (r < I_LRU) { const int mat = r >> 2, sub = r & 3;
            const int gate = mat >> 4, dn = mat & 15, dir = dn >> 3, n = dn & 7;
            const float* src = (gate ? p.lru_w_x : p.lru_w_a) + (size_t)dn * 128 * 128;
            transpose_item(src, 128, 128, wsb(p, OFF_LRUW) + (size_t)((dir * 2 + gate) * 8 + n) * 128 * 128, sub, tile, tid); continue; } r -= I_LRU;
        if (r < I_KEYS) { bf16_t* kd = wsb(p, OFF_KEYS); const int base = r * 4096 + tid * 8;
            const f32x4 a = *(const f32x4*)(p.peer_keys + base), b2 = *(const f32x4*)(p.peer_keys + base + 4);
            *(u32x4*)(kd + base) = pack8(a, b2); continue; } r -= I_KEYS;
        { float* z = wsf(p, OFF_QSS); const int base = r * 4096 + tid * 8;
            *(f32x4*)(z + base) = (f32x4){0.f, 0.f, 0.f, 0.f}; *(f32x4*)(z + base + 4) = (f32x4){0.f, 0.f, 0.f, 0.f}; }
    }
}
static_assert(OFF_KSS - OFF_QSS == (size_t)NB * 8 * SP * 4, "QSS/KSS contiguous");

__device__ __forceinline__ void norm_rows(const Ctx& F, const float* xlat, const float* xctx, int nrows, const float* nw, int shift_off, int scale_off, bf16_t* dst) {
    const float* mod = wsf(F.p, OFF_MOD);
    const int gw = F.c * 8 + F.wave, NGW = F.G * 8, lane = F.lane;
    f32x4 nv[4];
    if (gw < nrows) { const float* xr = gw < NT ? xlat + (size_t)gw * 1024 : xctx + (size_t)(gw - NT) * 1024;
#pragma unroll
        for (int j = 0; j < 4; ++j) nv[j] = *(const f32x4*)(xr + (lane + 64 * j) * 4); }
    for (int row = gw; row < nrows; row += NGW) {
        const int mb = row < NT ? (row >> 12) : 4;
        f32x4 v[4], w[4], sc[4], sh[4]; float s = 0.f;
#pragma unroll
        for (int j = 0; j < 4; ++j) { v[j] = nv[j]; s += v[j][0] * v[j][0] + v[j][1] * v[j][1] + v[j][2] * v[j][2] + v[j][3] * v[j][3]; }
        const int nrow = row + NGW;
        if (nrow < nrows) { const float* xr = nrow < NT ? xlat + (size_t)nrow * 1024 : xctx + (size_t)(nrow - NT) * 1024;
#pragma unroll
            for (int j = 0; j < 4; ++j) nv[j] = *(const f32x4*)(xr + (lane + 64 * j) * 4); }
#pragma unroll
        for (int j = 0; j < 4; ++j) { const int col = (lane + 64 * j) * 4; w[j] = *(const f32x4*)(nw + col); sc[j] = *(const f32x4*)(mod + mb * 6144 + scale_off + col); sh[j] = *(const f32x4*)(mod + mb * 6144 + shift_off + col); }
#pragma unroll
        for (int o = 1; o < 64; o <<= 1) s += __shfl_xor(s, o);
        const float rstd = rsqrtf(s * (1.f / 1024.f) + EPS);
#pragma unroll
        for (int j = 0; j < 4; ++j) { const int col = (lane + 64 * j) * 4;
            f32x4 h;
#pragma unroll
            for (int e = 0; e < 4; ++e) h[e] = v[j][e] * rstd * w[j][e] * (1.f + sc[j][e]) + sh[j][e];
            u32x2 o; o.x = cvt_pk_bf16(h[0], h[1]); o.y = cvt_pk_bf16(h[2], h[3]);
            *(u32x2*)(dst + (size_t)row * 1024 + col) = o; }
    }
}

__device__ __forceinline__ void attn_task(const Ctx& F, const LAS float* rpbs, int b, int r, int h, int qg) {
    const Params& p = F.p; const int lane = F.lane, fr = lane & 15, fq = lane >> 4;
    const bf16_t* Q = wsb(p, OFF_Q); const bf16_t* K = wsb(p, OFF_K); const bf16_t* VT = wsb(p, OFF_VT);
    const float* qss = wsf(p, OFF_QSS); const float* kss = wsf(p, OFF_KSS);
    const int tq = r * 64 + qg * 16 + fr, qc = qg * 16 + fr;
    const float LOG2E = 1.4426950408889634f;
    bf16x8 qf[2];
    { const float rq = rsqrtf(qss[(size_t)(b * 8 + h) * SP + tq] * (1.f / 64.f) + EPS) * 0.125f * LOG2E;
#pragma unroll
      for (int ks = 0; ks < 2; ++ks) { const int d0 = ks * 32 + fq * 8; const u32x4 raw = *(const u32x4*)(Q + (size_t)(b * SEQ + tq) * 512 + h * 64 + d0);
          const f32x4 wq0 = *(const f32x4*)(p.q_norm_w + d0), wq1 = *(const f32x4*)(p.q_norm_w + d0 + 4), wk0 = *(const f32x4*)(p.k_norm_w + d0), wk1 = *(const f32x4*)(p.k_norm_w + d0 + 4);
          f32x4 a, c2; a[0] = bflo(raw.x) * wq0[0] * wk0[0] * rq; a[1] = bfhi(raw.x) * wq0[1] * wk0[1] * rq; a[2] = bflo(raw.y) * wq0[2] * wk0[2] * rq; a[3] = bfhi(raw.y) * wq0[3] * wk0[3] * rq;
          c2[0] = bflo(raw.z) * wq1[0] * wk1[0] * rq; c2[1] = bfhi(raw.z) * wq1[1] * wk1[1] * rq; c2[2] = bflo(raw.w) * wq1[2] * wk1[2] * rq; c2[3] = bfhi(raw.w) * wq1[3] * wk1[3] * rq;
          const u32x4 pk = pack8(a, c2); qf[ks] = __builtin_bit_cast(bf16x8, pk); } }
    const int row0 = min(max(r - 4, 0), 56);
    const int nct = (qg == 0 || qg == 3) ? 2 : 3, ct0 = qg <= 1 ? 0 : qg - 1, nwin = 8 * nct, ntiles = nwin + 16;
    const int col0 = min(max(qc - 8, 0), 48);
    const size_t kbase = (size_t)b * SP * 512 + h * 64, ssbase = (size_t)(b * 8 + h) * SP, vbase = (size_t)(b * 8 + h) * 64 * SP;
    const LAS float* rp = rpbs + h * 465;
    f32x4 o[4]; for (int n = 0; n < 4; ++n) o[n] = (f32x4){0.f, 0.f, 0.f, 0.f};
    float mrun = -1e30f, lrun = 0.f;
    bf16x8 kA[4][2], kB[4][2]; f32x4 ssA[4], ssB[4]; int krA[4], ctA[4], krB[4], ctB[4], tbA[4], tbB[4];
#define ATT_LOAD(t0_, kk, ssx, tbx, krx, ctx) do { \
        _Pragma("unroll") for (int u = 0; u < 4; ++u) { const int ti = (t0_) + u; int tokb_; \
            if (ti < nwin) { krx[u] = row0 + ti / nct; ctx[u] = ct0 + ti % nct; tokb_ = krx[u] * 64 + ctx[u] * 16; } else { krx[u] = -1; ctx[u] = 0; tokb_ = 4096 + (ti - nwin) * 16; } \
            const bf16_t* kp = K + kbase + (size_t)(tokb_ + fr) * 512 + fq * 8; \
            kk[u][0] = *(const bf16x8*)kp; kk[u][1] = *(const bf16x8*)(kp + 32); \
            ssx[u] = *(const f32x4*)(kss + ssbase + tokb_ + 4 * fq); tbx[u] = tokb_; } } while (0)
#define ATT_COMPUTE(kk, ssx, tbx, krx, ctx) do { \
        u32x2 vv[4][4]; \
        _Pragma("unroll") for (int u = 0; u < 4; ++u) _Pragma("unroll") for (int n = 0; n < 4; ++n) vv[u][n] = *(const u32x2*)(VT + vbase + (size_t)(16 * n + fr) * SP + 4 * fq + tbx[u]); \
        f32x4 s[4]; \
        _Pragma("unroll") for (int u = 0; u < 4; ++u) { f32x4 a = (f32x4){0.f, 0.f, 0.f, 0.f}; \
            a = __builtin_amdgcn_mfma_f32_16x16x32_bf16(kk[u][0], qf[0], a, 0, 0, 0); \
            a = __builtin_amdgcn_mfma_f32_16x16x32_bf16(kk[u][1], qf[1], a, 0, 0, 0); \
            const bool win = krx[u] >= 0; \
            _Pragma("unroll") for (int j = 0; j < 4; ++j) { float v = a[j] * rsqrtf(ssx[u][j] * (1.f / 64.f) + EPS); \
                if (win) { const int kc = ctx[u] * 16 + 4 * fq + j; const int dc = min(max(kc - qc, -15), 15); \
                    const float bias = rp[(krx[u] - r + 7) * 31 + dc + 15]; \
                    v = (kc >= col0 && kc < col0 + 16) ? v + bias : -3.0e38f; } \
                a[j] = v; } \
            s[u] = a; } \
        float cm = s[0][0]; \
        _Pragma("unroll") for (int u = 0; u < 4; ++u) _Pragma("unroll") for (int j = 0; j < 4; ++j) cm = fmaxf(cm, s[u][j]); \
        cm = fmaxf(cm, __shfl_xor(cm, 16)); cm = fmaxf(cm, __shfl_xor(cm, 32)); \
        const float mnew = fmaxf(mrun, cm), alpha = __builtin_amdgcn_exp2f(mrun - mnew); mrun = mnew; \
        float ps = 0.f; \
        _Pragma("unroll") for (int u = 0; u < 4; ++u) _Pragma("unroll") for (int j = 0; j < 4; ++j) { s[u][j] = __builtin_amdgcn_exp2f(s[u][j] - mnew); ps += s[u][j]; } \
        lrun = lrun * alpha + ps; \
        _Pragma("unroll") for (int n = 0; n < 4; ++n) o[n] = o[n] * alpha; \
        _Pragma("unroll") for (int pr = 0; pr < 2; ++pr) { const u32x4 pk = pack8(s[2 * pr], s[2 * pr + 1]); const bf16x8 pf = __builtin_bit_cast(bf16x8, pk); \
            _Pragma("unroll") for (int n = 0; n < 4; ++n) { u32x4 vw; vw.x = vv[2 * pr][n].x; vw.y = vv[2 * pr][n].y; vw.z = vv[2 * pr + 1][n].x; vw.w = vv[2 * pr + 1][n].y; \
                o[n] = __builtin_amdgcn_mfma_f32_16x16x32_bf16(__builtin_bit_cast(bf16x8, vw), pf, o[n], 0, 0, 0); } } } while (0)
    ATT_LOAD(0, kA, ssA, tbA, krA, ctA);
    for (int t0 = 0; t0 < ntiles; t0 += 8) {
        ATT_LOAD(t0 + 4, kB, ssB, tbB, krB, ctB);
        __builtin_amdgcn_sched_barrier(0);
        ATT_COMPUTE(kA, ssA, tbA, krA, ctA);
        if (t0 + 8 < ntiles) ATT_LOAD(t0 + 8, kA, ssA, tbA, krA, ctA);
        __builtin_amdgcn_sched_barrier(0);
        ATT_COMPUTE(kB, ssB, tbB, krB, ctB);
    }
#undef ATT_LOAD
#undef ATT_COMPUTE
    lrun += __shfl_xor(lrun, 16); lrun += __shfl_xor(lrun, 32);
    const float inv = 1.f / lrun;
    bf16_t* op = wsb(p, OFF_OA) + (size_t)(b * SEQ + tq) * 512 + h * 64 + 4 * fq;
#pragma unroll
    for (int n = 0; n < 4; ++n) { u32x2 w; w.x = cvt_pk_bf16(o[n][0] * inv, o[n][1] * inv); w.y = cvt_pk_bf16(o[n][2] * inv, o[n][3] * inv); *(u32x2*)(op + 16 * n) = w; }
}


struct AttnPre { u32x4 kreg[2], vreg[2]; f32x4 sreg; u32x4 qraw[2]; float qssv; };
__device__ __forceinline__ void attn_prefetch(const Ctx& F, int b, int r, int hp, AttnPre& P) {
    const Params& p = F.p; const int tid = F.tid, lane = F.lane, fr = lane & 15, fq = lane >> 4, hh = F.wave >> 2, qg = F.wave & 3, h = hp * 2 + hh;
    const int tq = r * 64 + qg * 16 + fr, row0 = min(max(r - 4, 0), 56), tok0 = row0 * 64;
    const int lh = tid >> 8, idx = tid & 255, lhead = hp * 2 + lh;
    const bf16_t* kg = wsb(p, OFF_K) + (size_t)b * SP * 512 + lhead * 64; const bf16_t* vg = wsb(p, OFF_VT) + (size_t)(b * 8 + lhead) * 64 * SP; const float* sg = wsf(p, OFF_KSS) + (size_t)(b * 8 + lhead) * SP;
#pragma unroll
    for (int pp = 0; pp < 2; ++pp) { const int e = idx + 256 * pp, rowi = e >> 3, piece = e & 7;
        P.kreg[pp] = *(const u32x4*)(kg + (size_t)(tok0 + rowi) * 512 + piece * 8); P.vreg[pp] = *(const u32x4*)(vg + (size_t)rowi * SP + tok0 + piece * 8); }
    P.sreg = (f32x4){0.f, 0.f, 0.f, 0.f}; if (idx < 16) P.sreg = *(const f32x4*)(sg + tok0 + idx * 4);
#pragma unroll
    for (int ks = 0; ks < 2; ++ks) P.qraw[ks] = *(const u32x4*)(wsb(p, OFF_Q) + (size_t)(b * SEQ + tq) * 512 + h * 64 + ks * 32 + fq * 8);
    P.qssv = wsf(p, OFF_QSS)[(size_t)(b * 8 + h) * SP + tq];
}
__device__ __forceinline__ void attn_item(const Ctx& F, const LAS float* rpbs, int b, int r, int hp, AttnPre& P, bool has_next, int nb, int nr, int nhp) {
    const Params& p = F.p; const int tid = F.tid, lane = F.lane, fr = lane & 15, fq = lane >> 4, hh = F.wave >> 2, qg = F.wave & 3, h = hp * 2 + hh;
    const bf16_t* Q = wsb(p, OFF_Q); const bf16_t* K = wsb(p, OFF_K); const bf16_t* VT = wsb(p, OFF_VT);
    const float* qss = wsf(p, OFF_QSS); const float* kss = wsf(p, OFF_KSS);
    constexpr int KSTR = 72, BUFB = 2 * 64 * KSTR * 2 * 2 + 512;
    const int tq = r * 64 + qg * 16 + fr, qc = qg * 16 + fr;
    const float LOG2E = 1.4426950408889634f;
    bf16x8 qf[2];
    { const float rq = rsqrtf(P.qssv * (1.f / 64.f) + EPS) * 0.125f * LOG2E;
#pragma unroll
      for (int ks = 0; ks < 2; ++ks) { const int d0 = ks * 32 + fq * 8; const u32x4 raw = P.qraw[ks];
          const f32x4 wq0 = *(const f32x4*)(p.q_norm_w + d0), wq1 = *(const f32x4*)(p.q_norm_w + d0 + 4), wk0 = *(const f32x4*)(p.k_norm_w + d0), wk1 = *(const f32x4*)(p.k_norm_w + d0 + 4);
          f32x4 a, c2; a[0] = bflo(raw.x) * wq0[0] * wk0[0] * rq; a[1] = bfhi(raw.x) * wq0[1] * wk0[1] * rq; a[2] = bflo(raw.y) * wq0[2] * wk0[2] * rq; a[3] = bfhi(raw.y) * wq0[3] * wk0[3] * rq;
          c2[0] = bflo(raw.z) * wq1[0] * wk1[0] * rq; c2[1] = bfhi(raw.z) * wq1[1] * wk1[1] * rq; c2[2] = bflo(raw.w) * wq1[2] * wk1[2] * rq; c2[3] = bfhi(raw.w) * wq1[3] * wk1[3] * rq;
          const u32x4 pk = pack8(a, c2); qf[ks] = __builtin_bit_cast(bf16x8, pk); } }
    const int row0 = min(max(r - 4, 0), 56), col0 = min(max(qc - 8, 0), 48);
    const LAS float* rp = rpbs + h * 480; const float negM = -rpbs[8 * 15 * 32 + h];
    int boff[4][4];
#pragma unroll
    for (int ct = 0; ct < 4; ++ct)
#pragma unroll
        for (int j = 0; j < 4; ++j) { const int kc = ct * 16 + 4 * fq + j; const int dc = min(max(kc - qc, -15), 15); boff[ct][j] = (kc >= col0 && kc < col0 + 16) ? dc + 15 : 31; }
    const int lh = tid >> 8, idx = tid & 255, lhead = hp * 2 + lh;
    const bf16_t* kg = K + (size_t)b * SP * 512 + lhead * 64; const bf16_t* vg = VT + (size_t)(b * 8 + lhead) * 64 * SP; const float* sg = kss + (size_t)(b * 8 + lhead) * SP;
    u32x4 kreg[2], vreg[2]; f32x4 sreg = P.sreg; kreg[0] = P.kreg[0]; kreg[1] = P.kreg[1]; vreg[0] = P.vreg[0]; vreg[1] = P.vreg[1];
#define AT_ISSUE(c_) do { const int tok0_ = (c_) < 8 ? (row0 + (c_)) * 64 : 4096 + ((c_) - 8) * 64; \
        _Pragma("unroll") for (int pp = 0; pp < 2; ++pp) { const int e = idx + 256 * pp, rowi = e >> 3, piece = e & 7; \
            kreg[pp] = *(const u32x4*)(kg + (size_t)(tok0_ + rowi) * 512 + piece * 8); vreg[pp] = *(const u32x4*)(vg + (size_t)rowi * SP + tok0_ + piece * 8); } \
        if (idx < 16) sreg = *(const f32x4*)(sg + tok0_ + idx * 4); } while (0)
#define AT_WRITE(bi_) do { LAS unsigned char* bb_ = F.lds + (bi_) * BUFB; \
        _Pragma("unroll") for (int pp = 0; pp < 2; ++pp) { const int e = idx + 256 * pp, rowi = e >> 3, piece = e & 7; \
            *(LAS u32x4*)(bb_ + ((lh * 64 + rowi) * KSTR + piece * 8) * 2) = kreg[pp]; *(LAS u32x4*)(bb_ + 2 * 64 * KSTR * 2 + ((lh * 64 + rowi) * KSTR + piece * 8) * 2) = vreg[pp]; } \
        if (idx < 16) { f32x4 rk_; _Pragma("unroll") for (int j_ = 0; j_ < 4; ++j_) rk_[j_] = rsqrtf(sreg[j_] * (1.f / 64.f) + EPS); *(LAS f32x4*)(bb_ + 4 * 64 * KSTR * 2 + (lh * 64 + idx * 4) * 4) = rk_; } } while (0)
    f32x4 o[4]; for (int n = 0; n < 4; ++n) o[n] = (f32x4){0.f, 0.f, 0.f, 0.f};
    float lrun = 0.f;
    __syncthreads();
    AT_WRITE(0);
    __syncthreads();
    for (int c = 0; c < 12; ++c) {
        if (c + 1 < 12) AT_ISSUE(c + 1); else if (has_next) attn_prefetch(F, nb, nr, nhp, P);
        const LAS unsigned char* bb = F.lds + (c & 1) * BUFB;
        const LAS bf16_t* Kl = (const LAS bf16_t*)bb + hh * 64 * KSTR; const LAS bf16_t* Vl = (const LAS bf16_t*)(bb + 2 * 64 * KSTR * 2) + hh * 64 * KSTR;
        const LAS float* sl = (const LAS float*)(bb + 4 * 64 * KSTR * 2) + hh * 64;
        const bool win = c < 8; const int kr = row0 + c; const LAS float* rprow = rp + (win ? (kr - r + 7) * 32 : 0);
#pragma unroll
        for (int pr = 0; pr < 2; ++pr) {
            if (win && (pr == 0 ? qg == 3 : qg == 0)) continue;
            f32x4 s[2];
#pragma unroll
            for (int u = 0; u < 2; ++u) { const int ct = pr * 2 + u;
                const bf16x8 k0 = *(const LAS bf16x8*)(Kl + (ct * 16 + fr) * KSTR + fq * 8), k1 = *(const LAS bf16x8*)(Kl + (ct * 16 + fr) * KSTR + 32 + fq * 8);
                f32x4 a = (f32x4){0.f, 0.f, 0.f, 0.f};
                a = __builtin_amdgcn_mfma_f32_16x16x32_bf16(k0, qf[0], a, 0, 0, 0);
                a = __builtin_amdgcn_mfma_f32_16x16x32_bf16(k1, qf[1], a, 0, 0, 0);
                const f32x4 ss = *(const LAS f32x4*)(sl + ct * 16 + 4 * fq);
                if (win) {
#pragma unroll
                    for (int j = 0; j < 4; ++j) a[j] = a[j] * ss[j] + rprow[boff[ct][j]]; }
                else {
#pragma unroll
                    for (int j = 0; j < 4; ++j) a[j] = a[j] * ss[j] + negM; }
                s[u] = a; }
            float ps = 0.f;
#pragma unroll
            for (int u = 0; u < 2; ++u)
#pragma unroll
                for (int j = 0; j < 4; ++j) { s[u][j] = __builtin_amdgcn_exp2f(s[u][j]); ps += s[u][j]; }
            lrun += ps;
            const u32x4 pk = pack8(s[0], s[1]); const bf16x8 pf = __builtin_bit_cast(bf16x8, pk);
#pragma unroll
            for (int n = 0; n < 4; ++n) { const LAS bf16_t* vp = Vl + (16 * n + fr) * KSTR + pr * 32 + 4 * fq;
                const u32x2 v0 = *(const LAS u32x2*)vp, v1 = *(const LAS u32x2*)(vp + 16);
                u32x4 vw; vw.x = v0.x; vw.y = v0.y; vw.z = v1.x; vw.w = v1.y;
                o[n] = __builtin_amdgcn_mfma_f32_16x16x32_bf16(__builtin_bit_cast(bf16x8, vw), pf, o[n], 0, 0, 0); } }
        if (c + 1 < 12) AT_WRITE((c + 1) & 1);
        __syncthreads();
    }
#undef AT_ISSUE
#undef AT_WRITE
    lrun += __shfl_xor(lrun, 16); lrun += __shfl_xor(lrun, 32);
    const float inv = 1.f / lrun;
    bf16_t* op = wsb(p, OFF_OA) + (size_t)(b * SEQ + tq) * 512 + h * 64 + 4 * fq;
#pragma unroll
    for (int n = 0; n < 4; ++n) { u32x2 w; w.x = cvt_pk_bf16(o[n][0] * inv, o[n][1] * inv); w.y = cvt_pk_bf16(o[n][2] * inv, o[n][3] * inv); *(u32x2*)(op + 16 * n) = w; }
}

struct LruConst { bf16x8 wfr[4][4]; float ba0, bx0, ba1, bx1, la0, la1, w0[4], w1[4], cb0, cb1; int n; };
__device__ __forceinline__ void lru_load_const(const Ctx& F, int n, LruConst& C) {
    const Params& p = F.p; const int tid = F.tid, lane = F.lane, w = F.wave, fr = lane & 15, fq = lane >> 4;
    const bf16_t* LW = wsb(p, OFF_LRUW);
#pragma unroll
    for (int g = 0; g < 4; ++g)
#pragma unroll
        for (int ks = 0; ks < 4; ++ks) C.wfr[g][ks] = *(const bf16x8*)(LW + ((size_t)(g * 8 + n) * 128 + 16 * w + fr) * 128 + ks * 32 + fq * 8);
    const int ch = n * 128 + 16 * w + fr;
    C.ba0 = p.lru_b_a[ch]; C.bx0 = p.lru_b_x[ch]; C.ba1 = p.lru_b_a[1024 + ch]; C.bx1 = p.lru_b_x[1024 + ch];
    C.la0 = -8.f * log1pf(__expf(-p.lru_lambda[ch])); C.la1 = -8.f * log1pf(__expf(-p.lru_lambda[1024 + ch]));
    const int ch2 = n * 128 + 2 * (tid & 63);
#pragma unroll
    for (int j = 0; j < 4; ++j) { C.w0[j] = p.conv_w[j * 1024 + ch2]; C.w1[j] = p.conv_w[j * 1024 + ch2 + 1]; }
    C.cb0 = p.conv_b[ch2]; C.cb1 = p.conv_b[ch2 + 1]; C.n = n;
}
__device__ __forceinline__ void lru_load_x(const Ctx& F, int b, int ci, int n, unsigned (&xraw)[11]) {
    const int tid = F.tid; const bool lat = ci < 64; const int T = lat ? SEQ : CTX, t0 = lat ? ci * 64 : (ci - 64) * 64;
    const size_t rowbase = lat ? (size_t)b * SEQ : (size_t)NT + (size_t)b * CTX;
    const bf16_t* XR = wsb(F.p, OFF_XR); const int c2 = tid & 63, tg = tid >> 6, ch = n * 128 + 2 * c2;
#pragma unroll
    for (int i = 0; i < 11; ++i) { const int t = t0 + tg * 8 - 2 + i; unsigned raw = 0u; if (t >= 0 && t < T) raw = *(const unsigned*)(XR + (rowbase + t) * 1024 + ch); xraw[i] = raw; }
}
constexpr int LRU_BUF = 64 * 136 * 2 + 64 * 129 * 4;
__device__ __forceinline__ void lru_conv_to_lds(const Ctx& F, const LruConst& C, const unsigned (&xraw)[11], int buf) {
    const int tid = F.tid; LAS bf16_t* Ub = (LAS bf16_t*)(F.lds + buf * LRU_BUF); LAS float* Uf = (LAS float*)(F.lds + buf * LRU_BUF + 64 * 136 * 2);
    const int c2 = tid & 63, tg = tid >> 6;
#pragma unroll
    for (int tt = 0; tt < 8; ++tt) { const float u0 = C.cb0 + C.w0[0] * bflo(xraw[tt]) + C.w0[1] * bflo(xraw[tt + 1]) + C.w0[2] * bflo(xraw[tt + 2]) + C.w0[3] * bflo(xraw[tt + 3]);
        const float u1 = C.cb1 + C.w1[0] * bfhi(xraw[tt]) + C.w1[1] * bfhi(xraw[tt + 1]) + C.w1[2] * bfhi(xraw[tt + 2]) + C.w1[3] * bfhi(xraw[tt + 3]);
        const int tl = tg * 8 + tt; Uf[tl * 129 + 2 * c2] = u0; Uf[tl * 129 + 2 * c2 + 1] = u1; *(LAS unsigned*)(Ub + tl * 136 + 2 * c2) = cvt_pk_bf16(u0, u1); }
}
__device__ __forceinline__ void lru_gates(const Ctx& F, const LruConst& C, int buf, float (&af)[4][4], float (&bfw)[4][4], float (&ab)[4][4], float (&bb)[4][4]) {
    const int lane = F.lane, w = F.wave, fr = lane & 15, fq = lane >> 4;
    const LAS bf16_t* Ub = (const LAS bf16_t*)(F.lds + buf * LRU_BUF); const LAS float* Uf = (const LAS float*)(F.lds + buf * LRU_BUF + 64 * 136 * 2);
    f32x4 acc[4][4];
#pragma unroll
    for (int g = 0; g < 4; ++g)
#pragma unroll
        for (int tt = 0; tt < 4; ++tt) acc[g][tt] = (f32x4){0.f, 0.f, 0.f, 0.f};
#pragma unroll
    for (int ks = 0; ks < 4; ++ks) { bf16x8 afr[4];
#pragma unroll
        for (int tt = 0; tt < 4; ++tt) afr[tt] = *(const LAS bf16x8*)(Ub + (16 * tt + fr) * 136 + ks * 32 + fq * 8);
#pragma unroll
        for (int g = 0; g < 4; ++g)
#pragma unroll
            for (int tt = 0; tt < 4; ++tt) acc[g][tt] = __builtin_amdgcn_mfma_f32_16x16x32_bf16(afr[tt], C.wfr[g][ks], acc[g][tt], 0, 0, 0); }
#pragma unroll
    for (int tt = 0; tt < 4; ++tt)
#pragma unroll
        for (int j = 0; j < 4; ++j) { const float u = Uf[(16 * tt + 4 * fq + j) * 129 + 16 * w + fr];
            { const float rg = sigmoidf_(acc[0][tt][j] + C.ba0), ig = sigmoidf_(acc[1][tt][j] + C.bx0); const float a = __expf(rg * C.la0); af[tt][j] = rg; bfw[tt][j] = sqrtf(fmaxf(1.f - a * a, 0.f)) * ig * u; }
            { const float rg = sigmoidf_(acc[2][tt][j] + C.ba1), ig = sigmoidf_(acc[3][tt][j] + C.bx1); const float a = __expf(rg * C.la1); ab[tt][j] = rg; bb[tt][j] = sqrtf(fmaxf(1.f - a * a, 0.f)) * ig * u; } }
}
__device__ __forceinline__ float clamp_e4m3(float v) { return __builtin_amdgcn_fmed3f(v, -448.f, 448.f); }
__device__ __forceinline__ unsigned q4_fp8(float v0, float v1, float v2, float v3, float sc) { int w = 0; w = __builtin_amdgcn_cvt_pk_fp8_f32(clamp_e4m3(v0 * sc), clamp_e4m3(v1 * sc), w, false); w = __builtin_amdgcn_cvt_pk_fp8_f32(clamp_e4m3(v2 * sc), clamp_e4m3(v3 * sc), w, true); return (unsigned)w; }
__device__ __forceinline__ void lru_decode(const u32x4& rf, const u32x4& rb, const u32x4& bf8, const u32x4& bb8, float la0, float la1, float (&af)[4][4], float (&bfw)[4][4], float (&ab)[4][4], float (&bb)[4][4]) {
#pragma unroll
    for (int tt = 0; tt < 4; ++tt) {
        { const f32x2 lo = __builtin_amdgcn_cvt_pk_f32_fp8((int)rf[tt], false), hi = __builtin_amdgcn_cvt_pk_f32_fp8((int)rf[tt], true); const float k = la0 * (1.f / 256.f);
          af[tt][0] = __expf(lo.x * k); af[tt][1] = __expf(lo.y * k); af[tt][2] = __expf(hi.x * k); af[tt][3] = __expf(hi.y * k); }
        { const f32x2 lo = __builtin_amdgcn_cvt_pk_f32_fp8((int)rb[tt], false), hi = __builtin_amdgcn_cvt_pk_f32_fp8((int)rb[tt], true); const float k = la1 * (1.f / 256.f);
          ab[tt][0] = __expf(lo.x * k); ab[tt][1] = __expf(lo.y * k); ab[tt][2] = __expf(hi.x * k); ab[tt][3] = __expf(hi.y * k); }
        { const f32x2 lo = __builtin_amdgcn_cvt_pk_f32_fp8((int)bf8[tt], false), hi = __builtin_amdgcn_cvt_pk_f32_fp8((int)bf8[tt], true);
          bfw[tt][0] = lo.x * (1.f / 64.f); bfw[tt][1] = lo.y * (1.f / 64.f); bfw[tt][2] = hi.x * (1.f / 64.f); bfw[tt][3] = hi.y * (1.f / 64.f); }
        { const f32x2 lo = __builtin_amdgcn_cvt_pk_f32_fp8((int)bb8[tt], false), hi = __builtin_amdgcn_cvt_pk_f32_fp8((int)bb8[tt], true);
          bb[tt][0] = lo.x * (1.f / 64.f); bb[tt][1] = lo.y * (1.f / 64.f); bb[tt][2] = hi.x * (1.f / 64.f); bb[tt][3] = hi.y * (1.f / 64.f); } }
}

__device__ __forceinline__ void lru_summary_item(const Ctx& F, const LruConst& C, int item, int buf) {
    const int n = item & 7, ci = (item >> 3) % 68, b = (item >> 3) / 68; const int lane = F.lane, fr = lane & 15, fq = lane >> 4;
    float af[4][4], bfw[4][4], ab[4][4], bb[4][4]; const float la0 = C.la0, la1 = C.la1;
    lru_gates(F, C, buf, af, bfw, ab, bb);
    { u32x4 rf, rb, bf8, bb8;
#pragma unroll
      for (int tt = 0; tt < 4; ++tt) { rf[tt] = q4_fp8(af[tt][0], af[tt][1], af[tt][2], af[tt][3], 256.f); rb[tt] = q4_fp8(ab[tt][0], ab[tt][1], ab[tt][2], ab[tt][3], 256.f);
          bf8[tt] = q4_fp8(bfw[tt][0], bfw[tt][1], bfw[tt][2], bfw[tt][3], 64.f); bb8[tt] = q4_fp8(bb[tt][0], bb[tt][1], bb[tt][2], bb[tt][3], 64.f); }
      if (ci < 64) { u32x4* d = (u32x4*)(F.p.ws + OFF_LRD) + ((size_t)((b * 64 + ci) * 8 + n) * 4) * 512 + F.tid; d[0] = rf; d[512] = rb; d[1024] = bf8; d[1536] = bb8; }
      lru_decode(rf, rb, bf8, bb8, la0, la1, af, bfw, ab, bb); }
    float At = 1.f, Bt = 0.f;
#pragma unroll
    for (int tt = 0; tt < 4; ++tt) { float A = 1.f, B = 0.f;
#pragma unroll
        for (int j = 0; j < 4; ++j) { B = af[tt][j] * B + bfw[tt][j]; A = af[tt][j] * A; }
        { const float pA = __shfl_xor(A, 16), pB = __shfl_xor(B, 16); if ((fq & 1) == 0) { B = pA * B + pB; A = pA * A; } else { B = A * pB + B; A = A * pA; } }
        { const float pA = __shfl_xor(A, 32), pB = __shfl_xor(B, 32); if ((fq & 2) == 0) { B = pA * B + pB; A = pA * A; } else { B = A * pB + B; A = A * pA; } }
        Bt = A * Bt + B; At = A * At; }
    float Ar = 1.f, Br = 0.f;
#pragma unroll
    for (int tt = 3; tt >= 0; --tt) { float A = 1.f, B = 0.f;
#pragma unroll
        for (int j = 3; j >= 0; --j) { B = ab[tt][j] * B + bb[tt][j]; A = ab[tt][j] * A; }
        { const float pA = __shfl_xor(A, 16), pB = __shfl_xor(B, 16); if ((fq & 1) != 0) { B = pA * B + pB; A = pA * A; } else { B = A * pB + B; A = A * pA; } }
        { const float pA = __shfl_xor(A, 32), pB = __shfl_xor(B, 32); if ((fq & 2) != 0) { B = pA * B + pB; A = pA * A; } else { B = A * pB + B; A = A * pA; } }
        Br = A * Br + B; Ar = A * Ar; }
    if (fq == 0) { float* chk = wsf(F.p, OFF_CHK) + (size_t)(b * 68 + ci) * 4096 + n * 128 + 16 * F.wave + fr;
        chk[0] = At; chk[1024] = Bt; chk[2048] = Ar; chk[3072] = Br; }
}

__device__ __forceinline__ void lru_final_run(const Ctx& F, int run) {
    const Params& p = F.p; const int tid = F.tid, lane = F.lane, w = F.wave, fr = lane & 15, fq = lane >> 4;
    const int n = run & 7, r8 = (run >> 3) & 7, b = run >> 6;
    LAS float* carry = (LAS float*)(F.lds + 65536);
    __syncthreads();
    if (tid < 256) { const int dir = tid >> 7, cl = tid & 127; const float* chk = wsf(p, OFF_CHK) + (size_t)b * 68 * 4096 + dir * 2048 + n * 128 + cl;
        const int nsteps = dir == 0 ? 4 + r8 * 8 + 7 : 67 - r8 * 8; float h = 0.f;
        for (int s0 = 0; s0 <= nsteps; s0 += 8) { float A[8], Bv[8]; int cc[8];
#pragma unroll
            for (int u = 0; u < 8; ++u) { const int s = s0 + u; int cidx = dir == 0 ? (s < 4 ? 64 + s : s - 4) : 67 - s; cidx = min(max(cidx, 0), 67); cc[u] = cidx; A[u] = chk[(size_t)cidx * 4096]; Bv[u] = chk[(size_t)cidx * 4096 + 1024]; }
#pragma unroll
            for (int u = 0; u < 8; ++u) { const int s = s0 + u; if (s <= nsteps) { const int k = cc[u] - r8 * 8; if (k >= 0 && k < 8) carry[(dir * 8 + k) * 128 + cl] = h; if (s < nsteps) h = A[u] * h + Bv[u]; } } } }
    const bf16_t* YG = wsb(p, OFF_YG); bf16_t* OB = wsb(p, OFF_HBUF);
    LAS bf16_t* T = (LAS bf16_t*)F.lds;
    const int ch = n * 128 + 16 * w + fr;
    const float la0 = -8.f * log1pf(__expf(-p.lru_lambda[ch])), la1 = -8.f * log1pf(__expf(-p.lru_lambda[1024 + ch]));
    __syncthreads();
    u32x4 nrf, nrb, nbf, nbb, nyg0, nyg1;
    { const u32x4* d = (const u32x4*)(p.ws + OFF_LRD) + ((size_t)((b * 64 + r8 * 8) * 8 + n) * 4) * 512 + tid; nrf = __builtin_nontemporal_load(d); nrb = __builtin_nontemporal_load(d + 512); nbf = __builtin_nontemporal_load(d + 1024); nbb = __builtin_nontemporal_load(d + 1536);
      const size_t o0 = (size_t)(b * SEQ + r8 * 8 * 64 + (tid >> 3)) * 1024 + n * 128 + 16 * (tid & 7); nyg0 = *(const u32x4*)(YG + o0); nyg1 = *(const u32x4*)(YG + o0 + 8); }
    for (int k = 0; k < 8; ++k) { const int ci = r8 * 8 + k;
        float af[4][4], bfw[4][4], ab[4][4], bb[4][4];
        lru_decode(nrf, nrb, nbf, nbb, la0, la1, af, bfw, ab, bb);
        const size_t orow = (size_t)(b * SEQ + ci * 64 + (tid >> 3)) * 1024 + n * 128 + 16 * (tid & 7);
        const u32x4 yg0 = nyg0, yg1 = nyg1;
        if (k < 7) { const u32x4* d = (const u32x4*)(p.ws + OFF_LRD) + ((size_t)((b * 64 + ci + 1) * 8 + n) * 4) * 512 + tid; nrf = __builtin_nontemporal_load(d); nrb = __builtin_nontemporal_load(d + 512); nbf = __builtin_nontemporal_load(d + 1024); nbb = __builtin_nontemporal_load(d + 1536);
            nyg0 = *(const u32x4*)(YG + orow + 64 * 1024); nyg1 = *(const u32x4*)(YG + orow + 64 * 1024 + 8); }
        float hs = carry[(0 * 8 + k) * 128 + 16 * w + fr];
#pragma unroll
        for (int tt = 0; tt < 4; ++tt) { float A = 1.f, B = 0.f;
#pragma unroll
            for (int j = 0; j < 4; ++j) { B = af[tt][j] * B + bfw[tt][j]; A = af[tt][j] * A; }
            float PA[4], PB[4];
#pragma unroll
            for (int q = 0; q < 4; ++q) { PA[q] = __shfl(A, fr + 16 * q); PB[q] = __shfl(B, fr + 16 * q); }
            float e = hs;
#pragma unroll
            for (int q = 0; q < 3; ++q) if (q < fq) e = PA[q] * e + PB[q];
#pragma unroll
            for (int q = 0; q < 4; ++q) hs = PA[q] * hs + PB[q];
#pragma unroll
            for (int j = 0; j < 4; ++j) { e = af[tt][j] * e + bfw[tt][j]; af[tt][j] = e; } }
        hs = carry[(1 * 8 + k) * 128 + 16 * w + fr];
#pragma unroll
        for (int tt = 3; tt >= 0; --tt) { float A = 1.f, B = 0.f;
#pragma unroll
            for (int j = 3; j >= 0; --j) { B = ab[tt][j] * B + bb[tt][j]; A = ab[tt][j] * A; }
            float PA[4], PB[4];
#pragma unroll
            for (int q = 0; q < 4; ++q) { PA[q] = __shfl(A, fr + 16 * q); PB[q] = __shfl(B, fr + 16 * q); }
            float e = hs;
#pragma unroll
            for (int q = 3; q > 0; --q) if (q > fq) e = PA[q] * e + PB[q];
#pragma unroll
            for (int q = 3; q >= 0; --q) hs = PA[q] * hs + PB[q];
#pragma unroll
            for (int j = 3; j >= 0; --j) { e = ab[tt][j] * e + bb[tt][j]; af[tt][j] += e; } }
        __syncthreads();
#pragma unroll
        for (int tt = 0; tt < 4; ++tt)
#pragma unroll
            for (int j = 0; j < 4; j += 2) { const unsigned pk = cvt_pk_bf16(af[tt][j], af[tt][j + 1]);
                T[(16 * tt + 4 * fq + j) * 136 + 16 * w + fr] = (bf16_t)(pk & 0xffff); T[(16 * tt + 4 * fq + j + 1) * 136 + 16 * w + fr] = (bf16_t)(pk >> 16); }
        __syncthreads();
        { const LAS bf16_t* tp = T + (tid >> 3) * 136 + 16 * (tid & 7); const u32x4 h0 = *(const LAS u32x4*)tp, h1 = *(const LAS u32x4*)(tp + 8);
          u32x4 o0, o1;
#pragma unroll
          for (int q = 0; q < 4; ++q) { o0[q] = cvt_pk_bf16(bflo(h0[q]) * bflo(yg0[q]), bfhi(h0[q]) * bfhi(yg0[q])); o1[q] = cvt_pk_bf16(bflo(h1[q]) * bflo(yg1[q]), bfhi(h1[q]) * bfhi(yg1[q])); }
          *(u32x4*)(OB + orow) = o0; *(u32x4*)(OB + orow + 8) = o1; }
    }
}

template <int N> __device__ __forceinline__ void bitonic_sort_desc(unsigned (&v)[N]) {
#pragma unroll
    for (int k = 2; k <= N; k <<= 1)
#pragma unroll
        for (int j = k >> 1; j > 0; j >>= 1)
#pragma unroll
            for (int i = 0; i < N; ++i) { const int l = i ^ j; if (l > i) { const unsigned a = v[i], b2 = v[l]; const unsigned mx = a > b2 ? a : b2, mn = a > b2 ? b2 : a;
                    if ((i & k) == 0) { v[i] = mx; v[l] = mn; } else { v[i] = mn; v[l] = mx; } } }
}
__device__ __forceinline__ void merge_top16(unsigned (&a)[16], const unsigned (&b)[16]) {
#pragma unroll
    for (int i = 0; i < 16; ++i) a[i] = a[i] > b[15 - i] ? a[i] : b[15 - i];
#pragma unroll
    for (int j = 8; j > 0; j >>= 1)
#pragma unroll
        for (int i = 0; i < 16; ++i) { const int l = i ^ j; if (l > i) { const unsigned x = a[i], y = a[l]; a[i] = x > y ? x : y; a[l] = x > y ? y : x; } }
}
__device__ __forceinline__ unsigned f2key(float f) { const unsigned u = __float_as_uint(f); return (u & 0x80000000u) ? ~u : (u | 0x80000000u); }
__device__ __forceinline__ float key2f(unsigned k) { return __uint_as_float((k & 0x80000000u) ? (k ^ 0x80000000u) : ~k); }

__device__ __forceinline__ void peer_half_top16(const bf16_t* QP, const bf16_t* KEYS, int tok0, int h, int half, int fr, int fq, unsigned (&top)[16]) {
    bf16x8 qf[4];
#pragma unroll
    for (int ks = 0; ks < 4; ++ks) qf[ks] = *(const bf16x8*)(QP + (size_t)(tok0 + fr) * 2048 + h * 256 + half * 128 + ks * 32 + fq * 8);
    unsigned v[32];
#pragma unroll
    for (int kt = 0; kt < 8; ++kt) { f32x4 a = (f32x4){0.f, 0.f, 0.f, 0.f};
#pragma unroll
        for (int ks = 0; ks < 4; ++ks) { const bf16x8 kf = *(const bf16x8*)(KEYS + ((size_t)((h * 2 + half) * 128 + kt * 16 + fr)) * 128 + ks * 32 + fq * 8);
            a = __builtin_amdgcn_mfma_f32_16x16x32_bf16(kf, qf[ks], a, 0, 0, 0); }
#pragma unroll
        for (int j = 0; j < 4; ++j) v[kt * 4 + j] = (f2key(a[j]) & ~127u) | (unsigned)(kt * 16 + 4 * fq + j); }
    unsigned lo[16], hi[16];
#pragma unroll
    for (int i = 0; i < 16; ++i) { lo[i] = v[i]; hi[i] = v[16 + i]; }
    bitonic_sort_desc<16>(lo); bitonic_sort_desc<16>(hi); merge_top16(lo, hi);
    unsigned pb[16];
#pragma unroll
    for (int i = 0; i < 16; ++i) pb[i] = __shfl_xor(lo[i], 16);
    merge_top16(lo, pb);
#pragma unroll
    for (int i = 0; i < 16; ++i) pb[i] = __shfl_xor(lo[i], 32);
    merge_top16(lo, pb);
#pragma unroll
    for (int i = 0; i < 16; ++i) top[i] = lo[i];
}

__device__ __forceinline__ float dot2bf(unsigned a, unsigned b, float c) { return __builtin_amdgcn_fdot2_f32_bf16(__builtin_bit_cast(bf2_t, a), __builtin_bit_cast(bf2_t, b), c, false); }
__device__ __forceinline__ void peer_route_A(const Ctx& F, int item, int slot) {
    const Params& p = F.p; const int tid = F.tid, lane = F.lane, w = F.wave, fr = lane & 15, fq = lane >> 4;
    const int tok0 = item * 16;
    const bf16_t* QP = wsb(p, OFF_XR); const bf16_t* KEYS = wsb(p, OFF_KEYS); const bf16_t* H2 = wsb(p, OFF_HBUF);
    LAS unsigned* lA = (LAS unsigned*)F.lds;
    LAS unsigned* lB = lA + 8 * 16 * 16;
    LAS unsigned* lF = lB + 8 * 16 * 16;
    LAS int* eidx = (LAS int*)(lF + 8 * 16 * 16) + slot * 2048;
    LAS float* egate = (LAS float*)((LAS int*)(lF + 8 * 16 * 16) + 4 * 2048) + slot * 2048;
    LAS float* lG = (LAS float*)((LAS int*)(lF + 8 * 16 * 16) + 8 * 2048);
    __syncthreads();
    { const int h = w; unsigned A[16], Bk[16];
      peer_half_top16(QP, KEYS, tok0, h, 0, fr, fq, A);
      peer_half_top16(QP, KEYS, tok0, h, 1, fr, fq, Bk);
      float fa[16], fb[16];
#pragma unroll
      for (int i = 0; i < 16; ++i) { fa[i] = key2f(A[i] & ~127u); fb[i] = key2f(Bk[i] & ~127u); }
      unsigned g0[16];
      { const float av = fq == 0 ? fa[0] : fq == 1 ? fa[1] : fq == 2 ? fa[2] : fa[14], bv = fq == 0 ? fb[0] : fq == 1 ? fb[0] : fq == 2 ? fb[0] : fb[0]; const unsigned ix = fq == 0 ? 0u : fq == 1 ? 16u : fq == 2 ? 32u : 224u;
        g0[0] = (f2key(av + bv) & ~255u) | ix; }
      { const float av = fq == 0 ? fa[0] : fq == 1 ? fa[1] : fq == 2 ? fa[2] : fa[15], bv = fq == 0 ? fb[1] : fq == 1 ? fb[1] : fq == 2 ? fb[1] : fb[0]; const unsigned ix = fq == 0 ? 1u : fq == 1 ? 17u : fq == 2 ? 33u : 240u;
        g0[1] = (f2key(av + bv) & ~255u) | ix; }
      { const float av = fq == 0 ? fa[0] : fq == 1 ? fa[1] : fq == 2 ? fa[2] : 0.f, bv = fq == 0 ? fb[2] : fq == 1 ? fb[2] : fq == 2 ? fb[2] : 0.f; const unsigned ix = fq == 0 ? 2u : fq == 1 ? 18u : fq == 2 ? 34u : 0u;
        g0[2] = fq == 3 ? 0u : ((f2key(av + bv) & ~255u) | ix); }
      { const float av = fq == 0 ? fa[0] : fq == 1 ? fa[1] : fq == 2 ? fa[2] : 0.f, bv = fq == 0 ? fb[3] : fq == 1 ? fb[3] : fq == 2 ? fb[3] : 0.f; const unsigned ix = fq == 0 ? 3u : fq == 1 ? 19u : fq == 2 ? 35u : 0u;
        g0[3] = fq == 3 ? 0u : ((f2key(av + bv) & ~255u) | ix); }
      { const float av = fq == 0 ? fa[0] : fq == 1 ? fa[1] : fq == 2 ? fa[2] : 0.f, bv = fq == 0 ? fb[4] : fq == 1 ? fb[4] : fq == 2 ? fb[4] : 0.f; const unsigned ix = fq == 0 ? 4u : fq == 1 ? 20u : fq == 2 ? 36u : 0u;
        g0[4] = fq == 3 ? 0u : ((f2key(av + bv) & ~255u) | ix); }
      { const float av = fq == 0 ? fa[0] : fq == 1 ? fa[1] : fq == 2 ? fa[4] : 0.f, bv = fq == 0 ? fb[5] : fq == 1 ? fb[5] : fq == 2 ? fb[0] : 0.f; const unsigned ix = fq == 0 ? 5u : fq == 1 ? 21u : fq == 2 ? 64u : 0u;
        g0[5] = fq == 3 ? 0u : ((f2key(av + bv) & ~255u) | ix); }
      { const float av = fq == 0 ? fa[0] : fq == 1 ? fa[1] : fq == 2 ? fa[4] : 0.f, bv = fq == 0 ? fb[6] : fq == 1 ? fb[6] : fq == 2 ? fb[1] : 0.f; const unsigned ix = fq == 0 ? 6u : fq == 1 ? 22u : fq == 2 ? 65u : 0u;
        g0[6] = fq == 3 ? 0u : ((f2key(av + bv) & ~255u) | ix); }
      { const float av = fq == 0 ? fa[0] : fq == 1 ? fa[1] : fq == 2 ? fa[4] : 0.f, bv = fq == 0 ? fb[7] : fq == 1 ? fb[7] : fq == 2 ? fb[2] : 0.f; const unsigned ix = fq == 0 ? 7u : fq == 1 ? 23u : fq == 2 ? 66u : 0u;
        g0[7] = fq == 3 ? 0u : ((f2key(av + bv) & ~255u) | ix); }
      { const float av = fq == 0 ? fa[0] : fq == 1 ? fa[3] : fq == 2 ? fa[7] : 0.f, bv = fq == 0 ? fb[8] : fq == 1 ? fb[0] : fq == 2 ? fb[0] : 0.f; const unsigned ix = fq == 0 ? 8u : fq == 1 ? 48u : fq == 2 ? 112u : 0u;
        g0[8] = fq == 3 ? 0u : ((f2key(av + bv) & ~255u) | ix); }
      { const float av = fq == 0 ? fa[0] : fq == 1 ? fa[3] : fq == 2 ? fa[7] : 0.f, bv = fq == 0 ? fb[9] : fq == 1 ? fb[1] : fq == 2 ? fb[1] : 0.f; const unsigned ix = fq == 0 ? 9u : fq == 1 ? 49u : fq == 2 ? 113u : 0u;
        g0[9] = fq == 3 ? 0u : ((f2key(av + bv) & ~255u) | ix); }
      { const float av = fq == 0 ? fa[0] : fq == 1 ? fa[3] : fq == 2 ? fa[8] : 0.f, bv = fq == 0 ? fb[10] : fq == 1 ? fb[2] : fq == 2 ? fb[0] : 0.f; const unsigned ix = fq == 0 ? 10u : fq == 1 ? 50u : fq == 2 ? 128u : 0u;
        g0[10] = fq == 3 ? 0u : ((f2key(av + bv) & ~255u) | ix); }
      { const float av = fq == 0 ? fa[0] : fq == 1 ? fa[3] : fq == 2 ? fa[9] : 0.f, bv = fq == 0 ? fb[11] : fq == 1 ? fb[3] : fq == 2 ? fb[0] : 0.f; const unsigned ix = fq == 0 ? 11u : fq == 1 ? 51u : fq == 2 ? 144u : 0u;
        g0[11] = fq == 3 ? 0u : ((f2key(av + bv) & ~255u) | ix); }
      { const float av = fq == 0 ? fa[0] : fq == 1 ? fa[5] : fq == 2 ? fa[10] : 0.f, bv = fq == 0 ? fb[12] : fq == 1 ? fb[0] : fq == 2 ? fb[0] : 0.f; const unsigned ix = fq == 0 ? 12u : fq == 1 ? 80u : fq == 2 ? 160u : 0u;
        g0[12] = fq == 3 ? 0u : ((f2key(av + bv) & ~255u) | ix); }
      { const float av = fq == 0 ? fa[0] : fq == 1 ? fa[5] : fq == 2 ? fa[11] : 0.f, bv = fq == 0 ? fb[13] : fq == 1 ? fb[1] : fq == 2 ? fb[0] : 0.f; const unsigned ix = fq == 0 ? 13u : fq == 1 ? 81u : fq == 2 ? 176u : 0u;
        g0[13] = fq == 3 ? 0u : ((f2key(av + bv) & ~255u) | ix); }
      { const float av = fq == 0 ? fa[0] : fq == 1 ? fa[6] : fq == 2 ? fa[12] : 0.f, bv = fq == 0 ? fb[14] : fq == 1 ? fb[0] : fq == 2 ? fb[0] : 0.f; const unsigned ix = fq == 0 ? 14u : fq == 1 ? 96u : fq == 2 ? 192u : 0u;
        g0[14] = fq == 3 ? 0u : ((f2key(av + bv) & ~255u) | ix); }
      { const float av = fq == 0 ? fa[0] : fq == 1 ? fa[6] : fq == 2 ? fa[13] : 0.f, bv = fq == 0 ? fb[15] : fq == 1 ? fb[1] : fq == 2 ? fb[0] : 0.f; const unsigned ix = fq == 0 ? 15u : fq == 1 ? 97u : fq == 2 ? 208u : 0u;
        g0[15] = fq == 3 ? 0u : ((f2key(av + bv) & ~255u) | ix); }
      bitonic_sort_desc<16>(g0);
      { unsigned pb[16];
#pragma unroll
        for (int i = 0; i < 16; ++i) pb[i] = __shfl_xor(g0[i], 16);
        merge_top16(g0, pb);
#pragma unroll
        for (int i = 0; i < 16; ++i) pb[i] = __shfl_xor(g0[i], 32);
        merge_top16(g0, pb); }
      float pe[16]; float psum = 0.f; const float pm = key2f(g0[0] & ~255u);
#pragma unroll
      for (int i = 0; i < 16; ++i) { pe[i] = __expf(key2f(g0[i] & ~255u) - pm); psum += pe[i]; }
      const float pinv = 1.f / psum;
      if (fq == 0) { LAS unsigned* a = lA + (h * 16 + fr) * 16; LAS unsigned* b2 = lB + (h * 16 + fr) * 16; LAS unsigned* f = lF + (h * 16 + fr) * 16; LAS float* g = lG + (h * 16 + fr) * 16;
#pragma unroll
          for (int i = 0; i < 16; ++i) { a[i] = A[i]; b2[i] = Bk[i]; f[i] = g0[i]; g[i] = pe[i] * pinv; } } }
    __syncthreads();
#pragma unroll
    for (int r = 0; r < 4; ++r) { const int e = tid + 512 * r, sl = e & 15, h = (e >> 4) & 7, t = e >> 7;
        const LAS unsigned* f = lF + (h * 16 + t) * 16; const unsigned key = f[sl]; const int i = (key >> 4) & 15, j = key & 15;
        const int ia = lA[(h * 16 + t) * 16 + i] & 127, ib = lB[(h * 16 + t) * 16 + j] & 127;
        eidx[t * 128 + h * 16 + sl] = ia * 128 + ib; egate[t * 128 + h * 16 + sl] = lG[(h * 16 + t) * 16 + sl]; }
    __syncthreads();
    const unsigned char* U4 = p.ws + OFF_Q; const float* RS = (const float*)(p.ws + OFF_Q + (size_t)16 * 1024 * 1024);
    for (int tt = 0; tt < 2; ++tt) { const int tl = 2 * w + tt, tok = tok0 + tl;
        f32x2 hp[8];
        {
#pragma unroll
          for (int q = 0; q < 4; ++q) { const u32x2 hq = *(const u32x2*)(H2 + (size_t)tok * 1024 + 256 * q + 4 * lane);
              hp[2 * q] = (f32x2){bflo(hq.x), bfhi(hq.x)}; hp[2 * q + 1] = (f32x2){bflo(hq.y), bfhi(hq.y)}; } }
        const int myk = ((lane >> 5) & 1) * 8 + ((lane >> 4) & 1) * 4 + ((lane >> 3) & 1) * 2 + ((lane >> 2) & 1);
        const unsigned char* ubase = U4 + 8 * lane;
        const LAS int* el = eidx + tl * 128;
        u32x2 ub[2][16];
#pragma unroll
        for (int k = 0; k < 16; ++k) ub[0][k] = *(const u32x2*)(ubase + (size_t)__builtin_amdgcn_readfirstlane(el[k]) * 512);
#pragma unroll
        for (int hb = 0; hb < 8; ++hb) {
            if (hb < 7) {
#pragma unroll
                for (int k = 0; k < 16; ++k) ub[(hb + 1) & 1][k] = *(const u32x2*)(ubase + (size_t)__builtin_amdgcn_readfirstlane(el[(hb + 1) * 16 + k]) * 512); }
            const int emy = el[hb * 16 + myk]; const float rsu = RS[emy], rsv = RS[16384 + emy];
            __builtin_amdgcn_sched_barrier(0);
            float part[16];
#pragma unroll
            for (int k = 0; k < 16; ++k) { const u32x2 uw = ub[hb & 1][k];
                f32x2 a = __builtin_amdgcn_cvt_scalef32_pk_f32_fp4(uw.x, 1.0f, 0) * hp[0];
                a = __builtin_amdgcn_cvt_scalef32_pk_f32_fp4(uw.x, 1.0f, 1) * hp[1] + a;
                a = __builtin_amdgcn_cvt_scalef32_pk_f32_fp4(uw.x, 1.0f, 2) * hp[2] + a;
                a = __builtin_amdgcn_cvt_scalef32_pk_f32_fp4(uw.x, 1.0f, 3) * hp[3] + a;
                a = __builtin_amdgcn_cvt_scalef32_pk_f32_fp4(uw.y, 1.0f, 0) * hp[4] + a;
                a = __builtin_amdgcn_cvt_scalef32_pk_f32_fp4(uw.y, 1.0f, 1) * hp[5] + a;
                a = __builtin_amdgcn_cvt_scalef32_pk_f32_fp4(uw.y, 1.0f, 2) * hp[6] + a;
                a = __builtin_amdgcn_cvt_scalef32_pk_f32_fp4(uw.y, 1.0f, 3) * hp[7] + a;
                part[k] = a.x + a.y; }
            float r8[8], r4[4], r2[2], r1;
            { const bool hi = (lane & 32) != 0;
#pragma unroll
              for (int k = 0; k < 8; ++k) { const float keep = hi ? part[k + 8] : part[k], give = hi ? part[k] : part[k + 8]; r8[k] = keep + __shfl_xor(give, 32); } }
            { const bool hi = (lane & 16) != 0;
#pragma unroll
              for (int k = 0; k < 4; ++k) { const float keep = hi ? r8[k + 4] : r8[k], give = hi ? r8[k] : r8[k + 4]; r4[k] = keep + __shfl_xor(give, 16); } }
            { const bool hi = (lane & 8) != 0;
#pragma unroll
              for (int k = 0; k < 2; ++k) { const float keep = hi ? r4[k + 2] : r4[k], give = hi ? r4[k] : r4[k + 2]; r2[k] = keep + __shfl_xor(give, 8); } }
            { const bool hi = (lane & 4) != 0; const float keep = hi ? r2[1] : r2[0], give = hi ? r2[0] : r2[1]; r1 = keep + __shfl_xor(give, 4); }
            r1 += __shfl_xor(r1, 2); r1 += __shfl_xor(r1, 1);
            const float cfl = gelu_tanh(r1 * rsu) * egate[tl * 128 + hb * 16 + myk] * rsv;
            if ((lane & 3) == 0) egate[tl * 128 + hb * 16 + myk] = cfl;
        }
    }
}
__device__ __forceinline__ void peer_B(const Ctx& F, int item, int slot, bool dummy) {
    const Params& p = F.p; const int lane = F.lane, w = F.wave;
    const int tok0 = item * 16;
    const LAS int* eidx = (const LAS int*)((LAS unsigned*)F.lds + 3 * 8 * 16 * 16) + slot * 2048;
    const LAS float* coef = (const LAS float*)((const LAS int*)((LAS unsigned*)F.lds + 3 * 8 * 16 * 16) + 4 * 2048) + slot * 2048;
    const float* mod = wsf(p, OFF_MOD);
    const unsigned char* V4 = p.ws + OFF_Q + (size_t)16384 * 512;
    for (int tt = 0; tt < 2; ++tt) { const int tl = 2 * w + tt, tok = tok0 + tl, b = tok >> 12;
        f32x2 y[8];
#pragma unroll
        for (int i = 0; i < 8; ++i) y[i] = (f32x2){0.f, 0.f};
        const unsigned char* vbase = V4 + 8 * lane;
        const LAS int* el = eidx + tl * 128; const LAS float* cl = coef + tl * 128;
        u32x2 ub[2][16];
#pragma unroll
        for (int k = 0; k < 16; ++k) ub[0][k] = *(const u32x2*)(vbase + (size_t)__builtin_amdgcn_readfirstlane(el[k]) * 512);
#pragma unroll
        for (int hb = 0; hb < 8; ++hb) {
            if (hb < 7) {
#pragma unroll
                for (int k = 0; k < 16; ++k) ub[(hb + 1) & 1][k] = *(const u32x2*)(vbase + (size_t)__builtin_amdgcn_readfirstlane(el[(hb + 1) * 16 + k]) * 512); }
            __builtin_amdgcn_sched_barrier(0);
            const float cfl = cl[hb * 16 + (lane & 15)];
#pragma unroll
            for (int k = 0; k < 16; ++k) {
                const float cf = __uint_as_float(__builtin_amdgcn_readlane(__float_as_uint(cfl), k)); const f32x2 cf2 = (f32x2){cf, cf};
                const u32x2 vw = ub[hb & 1][k];
                y[0] = __builtin_amdgcn_cvt_scalef32_pk_f32_fp4(vw.x, 1.0f, 0) * cf2 + y[0]; y[1] = __builtin_amdgcn_cvt_scalef32_pk_f32_fp4(vw.x, 1.0f, 1) * cf2 + y[1];
                y[2] = __builtin_amdgcn_cvt_scalef32_pk_f32_fp4(vw.x, 1.0f, 2) * cf2 + y[2]; y[3] = __builtin_amdgcn_cvt_scalef32_pk_f32_fp4(vw.x, 1.0f, 3) * cf2 + y[3];
                y[4] = __builtin_amdgcn_cvt_scalef32_pk_f32_fp4(vw.y, 1.0f, 0) * cf2 + y[4]; y[5] = __builtin_amdgcn_cvt_scalef32_pk_f32_fp4(vw.y, 1.0f, 1) * cf2 + y[5];
                y[6] = __builtin_amdgcn_cvt_scalef32_pk_f32_fp4(vw.y, 1.0f, 2) * cf2 + y[6]; y[7] = __builtin_amdgcn_cvt_scalef32_pk_f32_fp4(vw.y, 1.0f, 3) * cf2 + y[7]; }
        }
        float* orow = p.out + (size_t)tok * 1024 + 4 * lane; const float* g2 = mod + b * 6144 + 5120 + 4 * lane;
#pragma unroll
        for (int q = 0; q < 4; ++q) { const f32x4 xv = __builtin_nontemporal_load((const f32x4*)(orow + 256 * q)), gv = *(const f32x4*)(g2 + 256 * q);
            f32x4 o; o[0] = xv[0] + gv[0] * y[2 * q].x; o[1] = xv[1] + gv[1] * y[2 * q].y; o[2] = xv[2] + gv[2] * y[2 * q + 1].x; o[3] = xv[3] + gv[3] * y[2 * q + 1].y;
            if (!dummy || o[0] == 12345.678f) __builtin_nontemporal_store(o, (f32x4*)(orow + 256 * q)); }
    }
}
__device__ __forceinline__ void peer_phase(const Ctx& F, bool dummy) {
    for (int base = F.c; base < 1024; base += 4 * F.G) {
#pragma unroll 1
        for (int j = 0; j < 4; ++j) { const int item = base + j * F.G; if (item < 1024) peer_route_A(F, item, j); }
        __syncthreads();
#pragma unroll 1
        for (int j = 0; j < 4; ++j) { const int item = base + j * F.G; if (item < 1024) peer_B(F, item, j, dummy); }
    }
}

#ifndef PEER_MODE
#define PEER_MODE 0
#endif
__device__ __forceinline__ void peer_route_simple(const Ctx& F) {
    const Params& p = F.p; const int tid = F.tid;
    const bf16_t* QP = wsb(p, OFF_XR); const bf16_t* KEYS = wsb(p, OFF_KEYS);
    int* eidxG = (int*)(p.ws + OFF_WINT); float* egateG = (float*)(p.ws + OFF_WINT + (size_t)8 * 1024 * 1024);
    LAS float* sc = (LAS float*)F.lds;
    for (int base = F.c * 128; base < 16384 * 8; base += F.G * 128) {
        if (tid < 128) { const int th = base + tid, tok = th >> 3, h = th & 7; LAS float* my = sc + tid * 257;
            for (int half = 0; half < 2; ++half) for (int k = 0; k < 128; ++k) { float d = 0.f;
                for (int dd = 0; dd < 128; ++dd) d += bf2f(QP[(size_t)tok * 2048 + h * 256 + half * 128 + dd]) * bf2f(KEYS[((size_t)(h * 2 + half) * 128 + k) * 128 + dd]);
                my[half * 128 + k] = d; }
            float ts[2][16]; int ti[2][16];
            for (int half = 0; half < 2; ++half) for (int r = 0; r < 16; ++r) { float best = -3e38f; int bi = 0; for (int k = 0; k < 128; ++k) { const float v = my[half * 128 + k]; if (v > best) { best = v; bi = k; } }
                my[half * 128 + bi] = -3e38f;
#pragma unroll
                for (int q = 0; q < 16; ++q) if (q == r) { ts[half][q] = best; ti[half][q] = bi; } }
#pragma unroll
            for (int i = 0; i < 16; ++i)
#pragma unroll
                for (int j = 0; j < 16; ++j) my[i * 16 + j] = ts[0][i] + ts[1][j];
            float bs[16]; int be[16];
            for (int r = 0; r < 16; ++r) { float best = -3e38f; int bi = 0; for (int k = 0; k < 256; ++k) { const float v = my[k]; if (v > best) { best = v; bi = k; } }
                my[bi] = -3e38f; int ia = 0, ib = 0;
#pragma unroll
                for (int q = 0; q < 16; ++q) { if (q == (bi >> 4)) ia = ti[0][q]; if (q == (bi & 15)) ib = ti[1][q]; }
#pragma unroll
                for (int q = 0; q < 16; ++q) if (q == r) { bs[q] = best; be[q] = ia * 128 + ib; } }
            float sum = 0.f;
#pragma unroll
            for (int q = 0; q < 16; ++q) sum += __expf(bs[q] - bs[0]);
#pragma unroll
            for (int q = 0; q < 16; ++q) { eidxG[(size_t)tok * 128 + h * 16 + q] = be[q]; egateG[(size_t)tok * 128 + h * 16 + q] = __expf(bs[q] - bs[0]) / sum; } }
    }
}
__device__ __forceinline__ void peer_gather_simple(const Ctx& F) {
    const Params& p = F.p; const int lane = F.lane;
    const bf16_t* H2 = wsb(p, OFF_HBUF); const bf16_t* UB = wsb(p, OFF_Q); const bf16_t* VB = UB + (size_t)16384 * 1024;
    const int* eidxG = (const int*)(p.ws + OFF_WINT); const float* egateG = (const float*)(p.ws + OFF_WINT + (size_t)8 * 1024 * 1024);
    const float* mod = wsf(p, OFF_MOD);
    for (int tok = F.c * 8 + F.wave; tok < 16384; tok += F.G * 8) { const int b = tok >> 12;
        float hv[16], y[16];
#pragma unroll
        for (int i = 0; i < 16; ++i) { hv[i] = bf2f(H2[(size_t)tok * 1024 + lane * 16 + i]); y[i] = 0.f; }
        for (int k = 0; k < 128; ++k) { const int e = eidxG[(size_t)tok * 128 + k]; const float g = egateG[(size_t)tok * 128 + k];
            float d = 0.f;
#pragma unroll
            for (int i = 0; i < 16; ++i) d += hv[i] * bf2f(UB[(size_t)e * 1024 + lane * 16 + i]);
#pragma unroll
            for (int o = 1; o < 64; o <<= 1) d += __shfl_xor(d, o);
            const float cf = gelu_tanh(d) * g;
#pragma unroll
            for (int i = 0; i < 16; ++i) y[i] += cf * bf2f(VB[(size_t)e * 1024 + lane * 16 + i]); }
#pragma unroll
        for (int i = 0; i < 16; ++i) { const int col = lane * 16 + i; p.out[(size_t)tok * 1024 + col] += mod[b * 6144 + 5120 + col] * y[i]; }
    }
}


#define XB_TMO      128
#define XB_XCNT(j)  (256  + 64 * (j))
#define XB_XSUB(j)  (1280 + 64 * (j))
#define XB_XGEN(j)  (2304 + 64 * (j))
#define XB_TOP      3328
#define XB_TOPGEN   3392
#define XCD_BAR_WORDS 3456
#define XB_SPIN_CAP (1u << 22)
__device__ __forceinline__ unsigned xb_ld(unsigned* p)              { return __hip_atomic_load(p, __ATOMIC_RELAXED, __HIP_MEMORY_SCOPE_AGENT); }
__device__ __forceinline__ unsigned xb_add(unsigned* p, unsigned v) { return __hip_atomic_fetch_add(p, v, __ATOMIC_RELAXED, __HIP_MEMORY_SCOPE_AGENT); }
__device__ __forceinline__ unsigned xb_xcc_id() { return (unsigned)__builtin_amdgcn_s_getreg((3 << 11) | 20) & 0xFu; }
#define XB_SPIN(cond, bar) do { unsigned _sp = 0; while (cond) { __builtin_amdgcn_s_sleep(1); \
    if ((++_sp & 255u) == 0u) { if (xb_ld(&(bar)[XB_TMO])) break; if (_sp > XB_SPIN_CAP) { atomicAdd(&(bar)[XB_TMO], 1u); break; } } } } while (0)
struct XcdBarrier { unsigned* bar; unsigned x; volatile LAS unsigned* st; };
__device__ __forceinline__ XcdBarrier xcd_barrier_post(unsigned* bar, volatile LAS unsigned* st) {
    XcdBarrier b; b.bar = bar; b.x = xb_xcc_id(); b.st = st;
    if (threadIdx.x == 0) (void)xb_add(&bar[XB_XCNT(b.x)], 1u);
    return b;
}
__device__ __forceinline__ void xcd_barrier_complete(unsigned* bar, unsigned x, unsigned& nloc, unsigned& nx) {
    const unsigned G = gridDim.x * gridDim.y * gridDim.z;
    unsigned sum, cnt, mine, sp = 0u;
    for (;;) {
        sum = 0u; cnt = 0u; mine = 0u;
#pragma unroll
        for (unsigned j = 0; j < 16; ++j) { const unsigned c = xb_ld(&bar[XB_XCNT(j)]); sum += c; cnt += (c > 0u) ? 1u : 0u; mine = (j == x) ? c : mine; }
        if (sum == G) break;
        __builtin_amdgcn_s_sleep(1);
        if ((++sp & 255u) == 0u) { if (xb_ld(&bar[XB_TMO])) break; if (sp > XB_SPIN_CAP) { atomicAdd(&bar[XB_TMO], 1u); break; } }
    }
    nloc = mine > 0u ? mine : 1u; nx = cnt > 0u ? cnt : 1u;
}
__device__ __forceinline__ void xcd_barrier(const XcdBarrier& b) {
    asm volatile("s_waitcnt vmcnt(0)" ::: "memory");
    __syncthreads();
    if (threadIdx.x == 0) {
        unsigned* bar = b.bar;
        __builtin_amdgcn_s_waitcnt(0);
        unsigned nloc = b.st[0], nx = b.st[1];
        if (nloc == 0u) { xcd_barrier_complete(bar, b.x, nloc, nx); b.st[0] = nloc; b.st[1] = nx; }
        const unsigned old = xb_add(&bar[XB_XSUB(b.x)], 1u);
        const unsigned gen = old / nloc;
        if (old + 1u == (gen + 1u) * nloc) {
            __builtin_amdgcn_fence(__ATOMIC_RELEASE, "agent");
            asm volatile("s_waitcnt vmcnt(0)" ::: "memory");
            const unsigned og = xb_add(&bar[XB_TOP], 1u);
            const unsigned tg = og / nx;
            if (og + 1u == (tg + 1u) * nx) xb_add(&bar[XB_TOPGEN], 1u);
            else XB_SPIN(xb_ld(&bar[XB_TOPGEN]) == tg, bar);
            __builtin_amdgcn_fence(__ATOMIC_ACQUIRE, "agent");
            xb_add(&bar[XB_XGEN(b.x)], 1u);
            asm volatile("s_waitcnt vmcnt(0)" ::: "memory");
        } else {
            XB_SPIN(xb_ld(&bar[XB_XGEN(b.x)]) == gen, bar);
            __builtin_amdgcn_fence(__ATOMIC_ACQUIRE, "agent");
            asm volatile("s_waitcnt vmcnt(0)" ::: "memory");
        }
    }
    __syncthreads();
}

constexpr int NPHASE = 10;
template <int PH, bool DUMMY = false> __device__ __forceinline__ void run_phase(const Ctx& F0) {
    Ctx F = F0; { int t_ = F0.tid; asm volatile("" : "+v"(t_)); F.tid = t_; F.lane = t_ & 63; }
    const Params& p = F.p;
    if (PH == 0) phase0(F);
    if (PH == 1) norm_rows(F, p.x, p.ctx, NR, p.norm1_w, 0, 1024, wsb(p, OFF_HBUF));
    if (PH == 2) { G1Order S; S.init(F.G, F.c);
        EpiG1 E{p.ws, (unsigned char*)p.out, DUMMY};
        pg8::gemm_phase<EpiG1, G1Order, GP_ALIGN, GP_SP2>(F.lds, pg8::Gemm{wsb(p, OFF_HBUF), wsb(p, OFF_WINT), NR, INC, 1024}, S, E);
        if (!DUMMY) { const int maxu = (1440 + F.G - 1) / F.G, c0 = 1440 - (maxu - 1) * F.G;
            int rank = F.c, stride = F.G; if (c0 < F.G) { if (F.c < c0) rank = -1; else { rank = F.c - c0; stride = F.G - c0; } }
            if (rank >= 0) { LAS float* tile = (LAS float*)F.lds;
                constexpr int I_WOA = 8 * 16, I_WOL = 16 * 16, I_WOUT = 16 * 16, I_WPQ = 16 * 32;
                for (int it = rank; it < I_WOA + I_WOL + I_WOUT + I_WPQ; it += stride) { int r = it;
                    if (r < I_WOA) { transpose_item(p.w_o_attn, 512, 1024, wsb(p, OFF_WOAT), r, tile, F.tid); continue; } r -= I_WOA;
                    if (r < I_WOL) { transpose_item(p.w_o_lru, 1024, 1024, wsb(p, OFF_WOLT), r, tile, F.tid); continue; } r -= I_WOL;
                    if (r < I_WOUT) { transpose_item(p.w_out, 1024, 1024, wsb(p, OFF_WOUTT), r, tile, F.tid); continue; } r -= I_WOUT;
                    transpose_item(p.peer_w_q, 1024, 2048, wsb(p, OFF_WPQT), r, tile, F.tid); } } } }
    if (PH == 3) {
        LAS float* rpbs = (LAS float*)(F.lds + 102400);
        LAS float* Mh = rpbs + 8 * 15 * 32;
        { float mw = fabsf(p.q_norm_w[F.lane] * p.k_norm_w[F.lane]), mb = 0.f;
#pragma unroll
          for (int i = 0; i < 8; ++i) { const int e = F.lane + 64 * i; if (e < 465) mb = fmaxf(mb, fabsf(p.na_rpb[F.wave * 465 + e])); }
#pragma unroll
          for (int o = 1; o < 64; o <<= 1) { mw = fmaxf(mw, __shfl_xor(mw, o)); mb = fmaxf(mb, __shfl_xor(mb, o)); }
          if (F.lane == 0) Mh[F.wave] = (8.f * mw + mb) * 1.4426950408889634f; }
        __syncthreads();
        for (int i = F.tid; i < 8 * 15 * 32; i += 512) { const int c31 = i & 31, hr = i >> 5; rpbs[i] = c31 < 31 ? p.na_rpb[hr * 31 + c31] * 1.4426950408889634f - Mh[hr / 15] : -3.0e38f; }
        __syncthreads();
#if PROBE_MASK & 1024
        if (DUMMY) return;
#endif
#if PROBE_MASK & 2048
        if (DUMMY) return;
#endif
        { LruConst C; C.n = -1; unsigned xraw[11]; int it = F.c;
          if (it < 2176) { lru_load_const(F, it & 7, C); lru_load_x(F, (it >> 3) / 68, (it >> 3) % 68, it & 7, xraw); lru_conv_to_lds(F, C, xraw, 0); }
          __syncthreads();
          for (int k = 0; it < 2176; it += F.G, k ^= 1) {
              const int nx = it + F.G;
              if (nx < 2176) lru_load_x(F, (nx >> 3) / 68, (nx >> 3) % 68, nx & 7, xraw);
              lru_summary_item(F, C, it, k);
              if (nx < 2176) { if ((nx & 7) != C.n) lru_load_const(F, nx & 7, C); lru_conv_to_lds(F, C, xraw, k ^ 1); }
              __syncthreads(); } }
        { AttnPre P; int a = F.c;
          if (a < 1024) attn_prefetch(F, a >> 8, (a >> 2) & 63, a & 3, P);
          for (; a < 1024; a += F.G) { const int na = a + F.G; attn_item(F, rpbs, a >> 8, (a >> 2) & 63, a & 3, P, na < 1024, na >> 8, (na >> 2) & 63, na & 3); } } }
    if (PH == 4) {
        const bool gemm_first = ((F.c >> 3) & 1) == 0;
        if (!gemm_first) { for (int run = F.c; run < 256; run += F.G) lru_final_run(F, run); __syncthreads(); }
        { pg8::StaticOrder S; S.init(NT, 1024, F.G, F.c); EpiBf<0> E{wsb(p, OFF_Q), (const bf16_t*)p.out, nullptr, 1024};
          pg8::gemm_phase<EpiBf<0>, pg8::StaticOrder, GP_ALIGN, GP_SP2>(F.lds, pg8::Gemm{wsb(p, OFF_OA), wsb(p, OFF_WOAT), NT, 1024, 512}, S, E); }
        if (gemm_first) { __syncthreads(); for (int run = F.c; run < 256; run += F.G) lru_final_run(F, run); } }
    if (PH == 5) {
        { pg8::StaticOrder S; S.init(NT, 1024, F.G, F.c); EpiBf<1> E{wsb(p, OFF_XR), (const bf16_t*)p.out + (size_t)NT * 1024, wsb(p, OFF_Q), 1024};
          pg8::gemm_phase<EpiBf<1>, pg8::StaticOrder, GP_ALIGN, GP_SP2>(F.lds, pg8::Gemm{wsb(p, OFF_HBUF), wsb(p, OFF_WOLT), NT, 1024, 1024}, S, E); } }
    if (PH == 6) { pg8::StaticOrder S; S.init(NT, 1024, F.G, F.c); EpiX1 E{p.out, p.x, wsf(p, OFF_MOD)};
        pg8::gemm_phase<EpiX1, pg8::StaticOrder, GP_ALIGN, GP_SP2>(F.lds, pg8::Gemm{wsb(p, OFF_XR), wsb(p, OFF_WOUTT), NT, 1024, 1024}, S, E); }
    if (PH == 7) {
        norm_rows(F, p.out, p.out, NT, p.norm2_w, 3072, 4096, wsb(p, OFF_HBUF));
        { unsigned char* q4 = p.ws + OFF_Q; float* RS = (float*)(p.ws + OFF_Q + (size_t)16 * 1024 * 1024);
          const int gw = F.c * 8 + F.wave, NGW = F.G * 8, lane = F.lane;
          f32x4 nv[4];
          if (gw < 32768) { const float* src = (gw < 16384 ? p.peer_u + (size_t)gw * 1024 : p.peer_v + (size_t)(gw - 16384) * 1024) + 4 * lane;
#pragma unroll
              for (int q = 0; q < 4; ++q) nv[q] = __builtin_nontemporal_load((const f32x4*)(src + 256 * q)); }
          for (int row = gw; row < 32768; row += NGW) {
              f32x4 v[4]; float ss = 0.f;
#pragma unroll
              for (int q = 0; q < 4; ++q) { v[q] = nv[q]; ss += v[q][0] * v[q][0] + v[q][1] * v[q][1] + v[q][2] * v[q][2] + v[q][3] * v[q][3]; }
              const int nrow = row + NGW;
              if (nrow < 32768) { const float* src = (nrow < 16384 ? p.peer_u + (size_t)nrow * 1024 : p.peer_v + (size_t)(nrow - 16384) * 1024) + 4 * lane;
#pragma unroll
                  for (int q = 0; q < 4; ++q) nv[q] = __builtin_nontemporal_load((const f32x4*)(src + 256 * q)); }
#pragma unroll
              for (int o = 1; o < 64; o <<= 1) ss += __shfl_xor(ss, o);
              const float sc = fmaxf(sqrtf(ss * (1.f / 1024.f)) * 0.5f, 1e-30f), inv = 1.f / sc;
              u32x2 o2;
#pragma unroll
              for (int d = 0; d < 2; ++d) { unsigned wv = 0u;
                  wv = __builtin_amdgcn_cvt_scalef32_pk_fp4_f32(wv, v[2 * d][0] * inv, v[2 * d][1] * inv, 1.0f, 0); wv = __builtin_amdgcn_cvt_scalef32_pk_fp4_f32(wv, v[2 * d][2] * inv, v[2 * d][3] * inv, 1.0f, 1);
                  wv = __builtin_amdgcn_cvt_scalef32_pk_fp4_f32(wv, v[2 * d + 1][0] * inv, v[2 * d + 1][1] * inv, 1.0f, 2); wv = __builtin_amdgcn_cvt_scalef32_pk_fp4_f32(wv, v[2 * d + 1][2] * inv, v[2 * d + 1][3] * inv, 1.0f, 3); o2[d] = wv; }
              *(u32x2*)(q4 + (size_t)row * 512 + 8 * lane) = o2;
              if (lane == 0) RS[row] = sc; } } }
    if (PH == 8) { pg8::StaticOrder S; S.init(NT, 2048, F.G, F.c); EpiBf<2> E{wsb(p, OFF_XR), nullptr, nullptr, 2048};
        pg8::gemm_phase<EpiBf<2>, pg8::StaticOrder, GP_ALIGN, GP_SP2>(F.lds, pg8::Gemm{wsb(p, OFF_HBUF), wsb(p, OFF_WPQT), NT, 2048, 1024}, S, E); }
#if PEER_MODE == 0
    if (PH == 9) peer_phase(F, DUMMY);
#else
    if (PH == 9) peer_route_simple(F);
    if (PH == 10) peer_gather_simple(F);
#endif
}

__device__ __forceinline__ Ctx make_ctx(const Params& p, LAS unsigned char* lds) {
    Ctx F; F.p = p; F.lds = lds; F.tid = threadIdx.x; F.lane = threadIdx.x & 63; F.wave = __builtin_amdgcn_readfirstlane(threadIdx.x >> 6); F.G = gridDim.x; F.c = blockIdx.x; return F;
}

#if MK_MULTI
template <int PH> __global__ void __launch_bounds__(512, 2) phase_kernel(Params p) {
    extern __shared__ __attribute__((aligned(16))) unsigned char lds_raw[];
    const Ctx F = make_ctx(p, (LAS unsigned char*)lds_raw);
    run_phase<PH>(F);
}
#else
__global__ void __launch_bounds__(512, 2) fwd_megakernel(Params p) {
    extern __shared__ __attribute__((aligned(16))) unsigned char lds_raw[];
    const Ctx F = make_ctx(p, (LAS unsigned char*)lds_raw);
    cg::grid_group grid = cg::this_grid();
    volatile LAS unsigned* xbst = (volatile LAS unsigned*)(F.lds + LDS_BYTES - 16);
    if (threadIdx.x == 0) { xbst[0] = 0u; xbst[1] = 0u; }
    __syncthreads();
    if (p.out == nullptr) grid.sync();
    const XcdBarrier xb = xcd_barrier_post((unsigned*)(p.ws + OFF_BAR), xbst);
#if PROBE_MASK & 1
    run_phase<0, true>(F); xcd_barrier(xb);
#endif
    run_phase<0>(F); xcd_barrier(xb);
#if PROBE_MASK & 2
    run_phase<1, true>(F); xcd_barrier(xb);
#endif
    run_phase<1>(F); xcd_barrier(xb);
#if PROBE_MASK & 4
    run_phase<2, true>(F); xcd_barrier(xb);
#endif
    run_phase<2>(F); xcd_barrier(xb);
#if PROBE_MASK & (8 | 1024 | 2048)
    run_phase<3, true>(F); xcd_barrier(xb);
#endif
    run_phase<3>(F); xcd_barrier(xb);
#if PROBE_MASK & 16
    run_phase<4, true>(F); xcd_barrier(xb);
#endif
    run_phase<4>(F); xcd_barrier(xb);
#if PROBE_MASK & 32
    run_phase<5, true>(F); xcd_barrier(xb);
#endif
    run_phase<5>(F); xcd_barrier(xb);
#if PROBE_MASK & 64
    run_phase<6, true>(F); xcd_barrier(xb);
#endif
    run_phase<6>(F); xcd_barrier(xb);
#if PROBE_MASK & 128
    run_phase<7, true>(F); xcd_barrier(xb);
#endif
    run_phase<7>(F); xcd_barrier(xb);
#if PROBE_MASK & 256
    run_phase<8, true>(F); xcd_barrier(xb);
#endif
    run_phase<8>(F); xcd_barrier(xb);
#if PROBE_MASK & 512
    run_phase<9, true>(F); xcd_barrier(xb);
#endif
    run_phase<9>(F);
}
#endif

extern "C" void kernel_launch(void* const* d_in, const int* in_sizes, int n_in, void* d_out, int out_size, void* d_ws, size_t ws_size, hipStream_t stream) {
    static int grid = 0;
    if (grid == 0) {
        if (n_in != 26 || ws_size < WS_END) { fprintf(stderr, "kernel_launch: unexpected n_in %d / ws %zu\n", n_in, ws_size); grid = -1; return; }
        int dev = 0, cus = 0; hipGetDevice(&dev); hipDeviceGetAttribute(&cus, hipDeviceAttributeMultiprocessorCount, dev);
#if MK_MULTI
        hipFuncSetAttribute((const void*)phase_kernel<0>, hipFuncAttributeMaxDynamicSharedMemorySize, LDS_BYTES);
        hipFuncSetAttribute((const void*)phase_kernel<1>, hipFuncAttributeMaxDynamicSharedMemorySize, LDS_BYTES);
        hipFuncSetAttribute((const void*)phase_kernel<2>, hipFuncAttributeMaxDynamicSharedMemorySize, LDS_BYTES);
        hipFuncSetAttribute((const void*)phase_kernel<3>, hipFuncAttributeMaxDynamicSharedMemorySize, LDS_BYTES);
        hipFuncSetAttribute((const void*)phase_kernel<4>, hipFuncAttributeMaxDynamicSharedMemorySize, LDS_BYTES);
        hipFuncSetAttribute((const void*)phase_kernel<5>, hipFuncAttributeMaxDynamicSharedMemorySize, LDS_BYTES);
        hipFuncSetAttribute((const void*)phase_kernel<6>, hipFuncAttributeMaxDynamicSharedMemorySize, LDS_BYTES);
        hipFuncSetAttribute((const void*)phase_kernel<7>, hipFuncAttributeMaxDynamicSharedMemorySize, LDS_BYTES);
        hipFuncSetAttribute((const void*)phase_kernel<8>, hipFuncAttributeMaxDynamicSharedMemorySize, LDS_BYTES);
        hipFuncSetAttribute((const void*)phase_kernel<9>, hipFuncAttributeMaxDynamicSharedMemorySize, LDS_BYTES);
#if PEER_MODE != 0
        hipFuncSetAttribute((const void*)phase_kernel<10>, hipFuncAttributeMaxDynamicSharedMemorySize, LDS_BYTES);
#endif
        grid = cus > 0 ? cus : 256;
#else
        hipFuncSetAttribute((const void*)fwd_megakernel, hipFuncAttributeMaxDynamicSharedMemorySize, LDS_BYTES);
        int per_cu = 0; hipOccupancyMaxActiveBlocksPerMultiprocessor(&per_cu, (const void*)fwd_megakernel, 512, LDS_BYTES);
        if (per_cu < 1) { fprintf(stderr, "kernel_launch: occupancy query says %d\n", per_cu); per_cu = 1; }
        grid = (cus > 0 ? cus : 256) * 1;
#endif
        (void)hipGetLastError();
    }
    if (grid < 0) return;
    Params p{};
    const float** pp = (const float**)&p;
    for (int i = 0; i < 26; ++i) pp[i] = (const float*)d_in[i];
    p.out = (float*)d_out; p.ws = (unsigned char*)d_ws;
#if MK_MULTI
    phase_kernel<0><<<grid, 512, LDS_BYTES, stream>>>(p);
    phase_kernel<1><<<grid, 512, LDS_BYTES, stream>>>(p);
    phase_kernel<2><<<grid, 512, LDS_BYTES, stream>>>(p);
    phase_kernel<3><<<grid, 512, LDS_BYTES, stream>>>(p);
    phase_kernel<4><<<grid, 512, LDS_BYTES, stream>>>(p);
    phase_kernel<5><<<grid, 512, LDS_BYTES, stream>>>(p);
    phase_kernel<6><<<grid, 512, LDS_BYTES, stream>>>(p);
    phase_kernel<7><<<grid, 512, LDS_BYTES, stream>>>(p);
    phase_kernel<8><<<grid, 512, LDS_BYTES, stream>>>(p);
    phase_kernel<9><<<grid, 512, LDS_BYTES, stream>>>(p);
#if PEER_MODE != 0
    phase_kernel<10><<<grid, 512, LDS_BYTES, stream>>>(p);
#endif
#else
    (void)hipMemsetAsync((unsigned char*)d_ws + OFF_BAR, 0, 16384, stream);
    void* args[] = {&p};
    hipError_t e = hipLaunchCooperativeKernel((const void*)fwd_megakernel, dim3(grid), dim3(512), args, LDS_BYTES, stream);
    if (e != hipSuccess) fprintf(stderr, "cooperative launch failed: %s (grid %d)\n", hipGetErrorString(e), grid);
#endif
}
```
